# Optimizing an MI355X kernel written in HIP

```python
import jax, jax.numpy as jnp
from jax import lax
import numpy as np

D_MODEL = 2048
BATCH = 2
SEQ = 16384
DEPTH = 1

GLA_HEADS = 4
GLA_DK = 128
GLA_DV = 256
GLA_WK = GLA_HEADS * GLA_DK
GLA_WV = GLA_HEADS * GLA_DV
GLA_GATE_RANK = 16
GLA_TAU = 16.0
GLA_CHUNK = 64

MOBA_HEADS = 8
MOBA_DH = 128
MOBA_W = MOBA_HEADS * MOBA_DH
MOBA_BLOCK = 256
MOBA_TOPK = 3
MOBA_QCHUNK = 64

NORM_EPS = 1e-6
NEG_BIG = -1e30

SPLIT_SIZES = (GLA_WK, GLA_WK, GLA_WV, GLA_GATE_RANK, GLA_WV,
               MOBA_W, MOBA_W, MOBA_W, MOBA_W, D_MODEL, D_MODEL)
PROJ_WIDTH = sum(SPLIT_SIZES)
SPLIT_POINTS = tuple(int(v) for v in np.cumsum(SPLIT_SIZES)[:-1])

kernel_name = "hybrid_gla_moba_gated_block"


def rms_norm(x, g):
    xf = x.astype(jnp.float32)
    y = xf * lax.rsqrt(jnp.mean(xf * xf, axis=-1, keepdims=True) + NORM_EPS)
    return (y * g.astype(jnp.float32)).astype(x.dtype)


def alibi_slopes(n_heads):
    return jnp.exp2(-8.0 * jnp.arange(1, n_heads + 1, dtype=jnp.float32) / n_heads)


def gla_chunked(q, k, v, log_a):
    B, S, H, dk = q.shape
    dv = v.shape[-1]
    C = GLA_CHUNK
    n = S // C
    f32 = jnp.float32

    def to_chunks(t):
        return t.astype(f32).reshape(B, n, C, H, t.shape[-1]).transpose(1, 0, 3, 2, 4)

    qs, ks, vs, gs = to_chunks(q), to_chunks(k), to_chunks(v), to_chunks(log_a)
    causal = jnp.tril(jnp.ones((C, C), dtype=bool))

    def step(state, inp):
        qc, kc, vc, gc = inp
        b = jnp.cumsum(gc, axis=2)
        o_inter = jnp.einsum('bhcd,bhde->bhce', qc * jnp.exp(b), state)
        diff = b[:, :, :, None, :] - b[:, :, None, :, :]
        decay = jnp.exp(jnp.where(causal[:, :, None], diff, -jnp.inf))
        attn = jnp.sum(qc[:, :, :, None, :] * kc[:, :, None, :, :] * decay, axis=-1)
        o_intra = jnp.einsum('bhij,bhje->bhie', attn, vc)
        b_last = b[:, :, -1:, :]
        state = (jnp.exp(b_last[:, :, 0, :, None]) * state
                 + jnp.einsum('bhcd,bhce->bhde', kc * jnp.exp(b_last - b), vc))
        return state, o_inter + o_intra

    s0 = jnp.zeros((B, H, dk, dv), f32)
    _, o = lax.scan(step, s0, (qs, ks, vs, gs))
    return o.transpose(1, 0, 3, 2, 4).reshape(B, S, H, dv).astype(v.dtype)


def moba_attention(q, k, v):
    B, H, S, dh = q.shape
    f32 = jnp.float32
    S_pad = -(-S // MOBA_BLOCK) * MOBA_BLOCK
    pad = S_pad - S
    padw = ((0, 0), (0, 0), (0, pad), (0, 0))
    q, k, v = jnp.pad(q, padw), jnp.pad(k, padw), jnp.pad(v, padw)
    nb = S_pad // MOBA_BLOCK
    n_sel = min(MOBA_TOPK, nb)
    kb = k.reshape(B, H, nb, MOBA_BLOCK, dh)
    vb = v.reshape(B, H, nb, MOBA_BLOCK, dh)

    k_mean = jnp.mean(kb.astype(f32), axis=3)
    gate = jnp.einsum('bhsd,bhnd->bhsn', q.astype(f32), k_mean)
    q_blk = jnp.arange(S_pad) // MOBA_BLOCK
    past = jnp.arange(nb)[None, :] < q_blk[:, None]
    gate = jnp.where(past[None, None], gate, -jnp.inf)
    _, sel = lax.top_k(gate, n_sel)

    QC = MOBA_QCHUNK
    n_qc = S_pad // QC
    q_c = q.reshape(B, H, n_qc, QC, dh).transpose(2, 0, 1, 3, 4)
    sel_c = sel.reshape(B, H, n_qc, QC, n_sel).transpose(2, 0, 1, 3, 4)
    slopes = alibi_slopes(H)
    scale = dh ** -0.5
    bi = jnp.arange(B)[:, None, None, None]
    hi = jnp.arange(H)[None, :, None, None]
    offs = jnp.arange(MOBA_BLOCK)

    def attend(inp):
        ci, qc, selc = inp
        t = ci * QC + jnp.arange(QC)
        own = (ci * QC) // MOBA_BLOCK
        k_own = lax.dynamic_index_in_dim(kb, own, axis=2, keepdims=False)
        v_own = lax.dynamic_index_in_dim(vb, own, axis=2, keepdims=False)
        k_g = kb[bi, hi, selc]
        v_g = vb[bi, hi, selc]
        s_sel = jnp.einsum('bhqd,bhqnjd->bhqnj', qc, k_g,
                           preferred_element_type=f32) * scale
        s_own = jnp.einsum('bhqd,bhjd->bhqj', qc, k_own,
                           preferred_element_type=f32) * scale
        pos_sel = selc[..., None] * MOBA_BLOCK + offs
        pos_own = own * MOBA_BLOCK + offs
        dist_sel = (t[None, None, :, None, None] - pos_sel).astype(f32)
        dist_own = (t[:, None] - pos_own[None, :]).astype(f32)
        s_sel = s_sel - slopes[None, :, None, None, None] * dist_sel
        s_own = s_own - slopes[None, :, None, None] * dist_own
        valid_sel = jnp.arange(n_sel)[None, :] < (t // MOBA_BLOCK)[:, None]
        s_sel = jnp.where(valid_sel[None, None, :, :, None], s_sel, NEG_BIG)
        s_own = jnp.where((pos_own[None, :] <= t[:, None])[None, None], s_own, NEG_BIG)
        scores = jnp.concatenate([s_sel.reshape(B, H, QC, n_sel * MOBA_BLOCK), s_own], axis=-1)
        p = jax.nn.softmax(scores, axis=-1)
        p_sel = p[..., :n_sel * MOBA_BLOCK].reshape(B, H, QC, n_sel, MOBA_BLOCK).astype(v.dtype)
        p_own = p[..., n_sel * MOBA_BLOCK:].astype(v.dtype)
        out = (jnp.einsum('bhqnj,bhqnjd->bhqd', p_sel, v_g, preferred_element_type=f32)
               + jnp.einsum('bhqj,bhjd->bhqd', p_own, v_own, preferred_element_type=f32))
        return out.astype(v.dtype)

    o = lax.map(attend, (jnp.arange(n_qc), q_c, sel_c))
    o = o.transpose(1, 2, 0, 3, 4).reshape(B, H, S_pad, dh)
    return o[:, :, :S]


def setup_inputs(seed: int = 0) -> dict:
    key = jax.random.key(seed)
    ks = jax.random.split(key, 12)
    nrm = jax.random.normal
    f32 = jnp.float32
    x = nrm(ks[0], (BATCH, SEQ, D_MODEL), f32)
    norm_g = 1.0 + 0.02 * nrm(ks[1], (DEPTH, D_MODEL), f32)
    w_in = nrm(ks[2], (DEPTH, D_MODEL, PROJ_WIDTH), f32) * D_MODEL ** -0.5
    w_gla_gate = nrm(ks[3], (DEPTH, GLA_GATE_RANK, GLA_WK), f32) * GLA_GATE_RANK ** -0.5
    b_gla_gate = 0.1 * nrm(ks[4], (DEPTH, GLA_WK), f32)
    gla_out_g = 1.0 + 0.02 * nrm(ks[5], (DEPTH, GLA_DV), f32)
    q_norm_g = 1.0 + 0.02 * nrm(ks[6], (DEPTH, MOBA_DH), f32)
    k_norm_g = 1.0 + 0.02 * nrm(ks[7], (DEPTH, MOBA_DH), f32)
    w_branch_gla = nrm(ks[8], (DEPTH, GLA_WV, D_MODEL), f32) * GLA_WV ** -0.5
    w_branch_moba = nrm(ks[9], (DEPTH, MOBA_W, D_MODEL), f32) * MOBA_W ** -0.5
    w_out = nrm(ks[10], (DEPTH, D_MODEL, D_MODEL), f32) * D_MODEL ** -0.5
    return {"x": x, "norm_g": norm_g, "w_in": w_in, "w_gla_gate": w_gla_gate,
            "b_gla_gate": b_gla_gate, "gla_out_g": gla_out_g, "q_norm_g": q_norm_g,
            "k_norm_g": k_norm_g, "w_branch_gla": w_branch_gla,
            "w_branch_moba": w_branch_moba, "w_out": w_out}


def reference(x, norm_g, w_in, w_gla_gate, b_gla_gate, gla_out_g, q_norm_g, k_norm_g,
              w_branch_gla, w_branch_moba, w_out):
    B, S, _ = x.shape
    for layer in range(DEPTH):
        h = rms_norm(x, norm_g[layer])
        proj = h @ w_in[layer]
        (g_q, g_k, g_v, g_lr, g_silu, m_q, m_k, m_v, m_silu,
         gate_a, gate_b) = jnp.split(proj, SPLIT_POINTS, axis=-1)

        q = g_q.reshape(B, S, GLA_HEADS, GLA_DK) * (GLA_DK ** -0.5)
        k = g_k.reshape(B, S, GLA_HEADS, GLA_DK)
        v = g_v.reshape(B, S, GLA_HEADS, GLA_DV)
        log_a = jax.nn.log_sigmoid(
            (g_lr @ w_gla_gate[layer] + b_gla_gate[layer]).astype(jnp.float32)) / GLA_TAU
        log_a = log_a.reshape(B, S, GLA_HEADS, GLA_DK)
        o_gla = gla_chunked(q, k, v, log_a)
        o_gla = rms_norm(o_gla, gla_out_g[layer]).reshape(B, S, GLA_WV) * jax.nn.silu(g_silu)
        z_gla = o_gla @ w_branch_gla[layer]

        mq = rms_norm(m_q.reshape(B, S, MOBA_HEADS, MOBA_DH), q_norm_g[layer]).transpose(0, 2, 1, 3)
        mk = rms_norm(m_k.reshape(B, S, MOBA_HEADS, MOBA_DH), k_norm_g[layer]).transpose(0, 2, 1, 3)
        mv = m_v.reshape(B, S, MOBA_HEADS, MOBA_DH).transpose(0, 2, 1, 3)
        o_moba = moba_attention(mq, mk, mv)
        o_moba = o_moba.transpose(0, 2, 1, 3).reshape(B, S, MOBA_W) * jax.nn.silu(m_silu)
        z_moba = o_moba @ w_branch_moba[layer]

        merged = jax.nn.sigmoid(gate_a) * z_gla + jax.nn.sigmoid(gate_b) * z_moba
        x = x + (merged @ w_out[layer]).astype(x.dtype)
    return x
```

```cpp
#include <hip/hip_runtime.h>
#include <cstdio>
#include <cstdint>
namespace pg8 {
#define PG8_LAS __attribute__((address_space(3)))
typedef unsigned short bf16_t;
typedef short bf16x8 __attribute__((ext_vector_type(8)));
typedef float f32x4 __attribute__((ext_vector_type(4)));
typedef unsigned u32x4 __attribute__((ext_vector_type(4)));
constexpr int BM = 256, BK = 64, HALF = 128, HTB = HALF * BK * 2  , STAGE_BYTES = 8 * HTB, NXCD = 8, WGM = 8;

__host__ __device__ __forceinline__ int lds_byte(int r, int c) { const int st = (r >> 4) * 2 + (c >> 5), rr = r & 15, cc = c & 31, ob = rr * 64 + cc * 2; return st * 1024 + (ob ^ (((ob >> 9) & 1) << 5)); }
__host__ __device__ __forceinline__ void stage_rc(int b, int& R, int& C) { const int st = b / 1024, sb = b % 1024, swz = sb ^ (((sb >> 9) & 1) << 5); R = (st >> 1) * 16 + swz / 64; C = (st & 1) * 32 + (swz % 64) / 2; }
__host__ __device__ __forceinline__ int perm32(int rho) { const int n = rho >> 4, i = rho & 15; return 8 * (i >> 2) + 4 * n + (i & 3); }

struct Unit { int pm, pn; };
struct Gemm { const bf16_t* A; const bf16_t* Bt; int M, N, K; };

struct StaticOrder {
    int nM, nN, nwg, G, c;
    __host__ __device__ void init(int M, int N, int G_, int c_) { nM = M / BM; nN = N / BM; nwg = nM * nN; G = G_; c = c_; }
    __host__ __device__ bool next(int i, Unit& u) const {
        const long L = (long)i * G + c; if (L >= nwg) return false;
        int wgid = (int)L; { const int q = nwg / NXCD, r = nwg % NXCD, xcd = wgid % NXCD, off = wgid / NXCD; wgid = (xcd < r ? xcd * (q + 1) : r * (q + 1) + (xcd - r) * q) + off; }
        const int nig = WGM * nN, gid = wgid / nig, fm = gid * WGM, gsz = (nM - fm) < WGM ? (nM - fm) : WGM;
        u.pm = fm + ((wgid % nig) % gsz); u.pn = (wgid % nig) / gsz; return true;
    }
    __device__ __forceinline__ void a_ready(const Unit&) const {}
    __device__ __forceinline__ void done(const Unit&) const {}
};

__device__ __forceinline__ unsigned cvt_pk_bf16(float lo, float hi) { unsigned r; asm volatile("v_cvt_pk_bf16_f32 %0, %1, %2" : "=v"(r) : "v"(lo), "v"(hi)); return r; }

template <class Epi, class Sched, bool ALIGN_EPI = false, bool SP2 = false>
__device__ __forceinline__ void gemm_phase(PG8_LAS unsigned char* lds, const Gemm g, const Sched& S, const Epi& E) {
    const int tid = threadIdx.x, wid = __builtin_amdgcn_readfirstlane(tid >> 6), lane = tid & 63, wr = wid >> 2, wc = wid & 3, fr = lane & 15, fq = lane >> 4;
    const int K = g.K, nt = K / BK;
    unsigned voffA[2], voffB[2];
#pragma unroll
    for (int i = 0; i < 2; ++i) { int R, C; stage_rc(tid * 16 + i * 8192, R, C); const int Rb = Epi::PERM ? ((R & ~31) + perm32(R & 31)) : R;
        voffA[i] = (unsigned)(R * K + C) * 2u; voffB[i] = (unsigned)(Rb * K + C) * 2u; }
    const size_t kstep = (size_t)(BK * 2);
    const size_t hstep = (size_t)HALF * K * 2;
    const size_t tstep = 2 * hstep;
    const unsigned ldsw = (unsigned)wid * 1024u;
    const int aoff = lds_byte(wr * 64 + fr, fq * 8), boff = lds_byte(wc * 32 + fr, fq * 8);
#define PG8_SA(b, h) (((b) * 2 + (h)) * HTB)
#define PG8_SB(b, h) ((4 + (b) * 2 + (h)) * HTB)
#define PG8_STAGE(bufoff, gbase, voff) do { _Pragma("unroll") for (int _i = 0; _i < 2; ++_i) \
        __builtin_amdgcn_global_load_lds((const unsigned*)((const char*)(gbase) + (voff)[_i]), (PG8_LAS unsigned*)(lds + (bufoff) + ldsw + _i * 8192), 16, 0, 0); } while (0)
#define PG8_LDA(dst, b, h) do { _Pragma("unroll") for (int m = 0; m < 4; ++m) _Pragma("unroll") for (int k = 0; k < 2; ++k) dst[m][k] = *(const PG8_LAS bf16x8*)(lds + PG8_SA(b, h) + aoff + m * 2048 + k * 1024); } while (0)
#define PG8_LDB(dst, b, h) do { _Pragma("unroll") for (int n = 0; n < 2; ++n) _Pragma("unroll") for (int k = 0; k < 2; ++k) dst[n][k] = *(const PG8_LAS bf16x8*)(lds + PG8_SB(b, h) + boff + n * 2048 + k * 1024); } while (0)
#define PG8_MMA(ai, bj, At, Bt) do { __builtin_amdgcn_s_setprio(1); _Pragma("unroll") for (int m = 0; m < 4; ++m) _Pragma("unroll") for (int n = 0; n < 2; ++n) _Pragma("unroll") for (int k = 0; k < 2; ++k) \
        acc[ai][bj][m][n] = __builtin_amdgcn_mfma_f32_16x16x32_bf16(Bt[n][k], At[m][k], acc[ai][bj][m][n], 0, 0, 0); __builtin_amdgcn_s_setprio(0); } while (0)
#define PG8_WAIT_V(n) asm volatile("s_waitcnt vmcnt(" #n ")" ::: "memory")
#define PG8_WAIT_L(n) asm volatile("s_waitcnt lgkmcnt(" #n ")" ::: "memory")
#define PG8_BAR __builtin_amdgcn_s_barrier()
#define PG8_SCHED __builtin_amdgcn_sched_barrier(0)
    Unit cur, nxt; int ui = 0;
    if (!S.next(0, cur)) return;
    f32x4 acc[2][2][4][2];
#pragma unroll
    for (int a = 0; a < 2; ++a)
#pragma unroll
        for (int b = 0; b < 2; ++b)
#pragma unroll
            for (int m = 0; m < 4; ++m)
#pragma unroll
                for (int n = 0; n < 2; ++n) acc[a][b][m][n] = (f32x4){0.f, 0.f, 0.f, 0.f};
    bf16x8 At[4][2], B0[2][2], B1[2][2];
    const char* cA = (const char*)g.A + (size_t)cur.pm * tstep; const char* cB = (const char*)g.Bt + (size_t)cur.pn * tstep;
    S.a_ready(cur);
    if constexpr (SP2) {
        PG8_STAGE(PG8_SB(0, 0), cB, voffB); PG8_STAGE(PG8_SB(0, 1), cB + hstep, voffB); PG8_STAGE(PG8_SA(0, 0), cA, voffA); PG8_STAGE(PG8_SA(0, 1), cA + hstep, voffA);
        if (wr == 1) PG8_BAR;
        PG8_WAIT_V(2); PG8_BAR;
        PG8_STAGE(PG8_SB(1, 0), cB + kstep, voffB); PG8_STAGE(PG8_SA(1, 0), cA + kstep, voffA); PG8_STAGE(PG8_SB(1, 1), cB + hstep + kstep, voffB);
        PG8_WAIT_V(6); PG8_BAR;
    } else {
        PG8_STAGE(PG8_SB(0, 0), cB, voffB); PG8_STAGE(PG8_SA(0, 0), cA, voffA); PG8_STAGE(PG8_SB(0, 1), cB + hstep, voffB); PG8_STAGE(PG8_SA(0, 1), cA + hstep, voffA);
        if (wr == 1) PG8_BAR;
        PG8_WAIT_V(4); PG8_BAR;
        PG8_STAGE(PG8_SB(1, 0), cB + kstep, voffB); PG8_STAGE(PG8_SA(1, 0), cA + kstep, voffA); PG8_STAGE(PG8_SB(1, 1), cB + hstep + kstep, voffB);
        PG8_WAIT_V(6); PG8_BAR;
    }
    for (;;) {
        const bool has_next = S.next(ui + 1, nxt);
        const char* nA = has_next ? (const char*)g.A + (size_t)nxt.pm * tstep : cA; const char* nB = has_next ? (const char*)g.Bt + (size_t)nxt.pn * tstep : cB;
        for (int t = 0; t < nt; t += 2) {
            if constexpr (Epi::MID_HOOK) { if (t == nt / 2) E.mid(acc, cur, wr, wc, fr, fq); }
            const bool last = (t == nt - 2);
            const char* a1 = cA + (size_t)(t + 1) * kstep;
            const char* a2 = last ? nA : cA + (size_t)(t + 2) * kstep; const char* b2 = last ? nB : cB + (size_t)(t + 2) * kstep;
            const char* a3 = a2 + kstep; const char* b3 = b2 + kstep;
            if (last && has_next) S.a_ready(nxt);
            if constexpr (SP2) {
            PG8_LDB(B0, 0, 0); PG8_LDB(B1, 0, 1); PG8_SCHED; PG8_LDA(At, 0, 0); PG8_STAGE(PG8_SA(1, 1), a1 + hstep, voffA);
            PG8_WAIT_V(8); PG8_WAIT_L(0); PG8_BAR; PG8_MMA(0, 0, At, B0); PG8_MMA(0, 1, At, B1); PG8_BAR; PG8_SCHED;
            PG8_LDA(At, 0, 1); PG8_STAGE(PG8_SB(0, 0), b2, voffB); PG8_STAGE(PG8_SB(0, 1), b2 + hstep, voffB); PG8_STAGE(PG8_SA(0, 0), a2, voffA);
            PG8_WAIT_V(8); PG8_WAIT_L(0); PG8_BAR; PG8_MMA(1, 0, At, B0); PG8_MMA(1, 1, At, B1); PG8_BAR; PG8_SCHED;
            PG8_LDB(B0, 1, 0); PG8_LDB(B1, 1, 1); PG8_SCHED; PG8_LDA(At, 1, 0); PG8_STAGE(PG8_SA(0, 1), a2 + hstep, voffA);
            PG8_WAIT_V(8); PG8_WAIT_L(0); PG8_BAR; PG8_MMA(0, 0, At, B0); PG8_MMA(0, 1, At, B1); PG8_BAR; PG8_SCHED;
            PG8_LDA(At, 1, 1); PG8_STAGE(PG8_SB(1, 0), b3, voffB); PG8_STAGE(PG8_SB(1, 1), b3 + hstep, voffB); PG8_STAGE(PG8_SA(1, 0), a3, voffA);
            PG8_WAIT_V(8); PG8_WAIT_L(0); PG8_BAR; PG8_MMA(1, 0, At, B0); PG8_MMA(1, 1, At, B1); PG8_BAR; PG8_SCHED;
            } else {
            PG8_LDB(B0, 0, 0); PG8_SCHED; PG8_LDA(At, 0, 0); PG8_STAGE(PG8_SA(1, 1), a1 + hstep, voffA);
            PG8_WAIT_L(8); PG8_BAR; PG8_WAIT_L(0); PG8_MMA(0, 0, At, B0); PG8_BAR; PG8_SCHED;
            PG8_LDB(B1, 0, 1); PG8_STAGE(PG8_SB(0, 0), b2, voffB);
            PG8_BAR; PG8_WAIT_L(0); PG8_MMA(0, 1, At, B1); PG8_BAR;
            PG8_LDA(At, 0, 1); PG8_STAGE(PG8_SA(0, 0), a2, voffA);
            PG8_BAR; PG8_WAIT_L(0); PG8_MMA(1, 0, At, B0); PG8_BAR; PG8_SCHED;
            PG8_STAGE(PG8_SB(0, 1), b2 + hstep, voffB);
            PG8_WAIT_V(6); PG8_BAR; PG8_MMA(1, 1, At, B1); PG8_BAR;
            PG8_LDB(B0, 1, 0); PG8_SCHED; PG8_LDA(At, 1, 0); PG8_STAGE(PG8_SA(0, 1), a2 + hstep, voffA);
            PG8_WAIT_L(8); PG8_BAR; PG8_WAIT_L(0); PG8_MMA(0, 0, At, B0); PG8_BAR; PG8_SCHED;
            PG8_LDB(B1, 1, 1); PG8_STAGE(PG8_SB(1, 0), b3, voffB);
            PG8_BAR; PG8_WAIT_L(0); PG8_MMA(0, 1, At, B1); PG8_BAR;
            PG8_LDA(At, 1, 1); PG8_STAGE(PG8_SA(1, 0), a3, voffA);
            PG8_BAR; PG8_WAIT_L(0); PG8_MMA(1, 0, At, B0); PG8_BAR; PG8_SCHED;
            PG8_STAGE(PG8_SB(1, 1), b3 + hstep, voffB);
            PG8_WAIT_V(6); PG8_BAR; PG8_MMA(1, 1, At, B1); PG8_BAR;
            }
        }
        if constexpr (ALIGN_EPI) { if (wr == 0) PG8_BAR; }
        if constexpr (!Epi::AFTER_DRAIN) { E(acc, cur, wr, wc, fr, fq); S.done(cur); }
        if (!has_next) break;
#pragma unroll
        for (int a = 0; a < 2; ++a)
#pragma unroll
            for (int b = 0; b < 2; ++b)
#pragma unroll
                for (int m = 0; m < 4; ++m)
#pragma unroll
                    for (int n = 0; n < 2; ++n) acc[a][b][m][n] = (f32x4){0.f, 0.f, 0.f, 0.f};
        cur = nxt; cA = nA; cB = nB; ++ui;
        if constexpr (ALIGN_EPI) { if (wr == 1) PG8_BAR; }
    }
    PG8_WAIT_V(0);
    if constexpr (!ALIGN_EPI) { if (wr == 0) PG8_BAR; }
    PG8_BAR;
    if constexpr (Epi::AFTER_DRAIN) { E.fused(acc, cur, wr, wc, fr, fq, lds, wid, lane); S.done(cur); }
#undef PG8_SA
#undef PG8_SB
#undef PG8_STAGE
#undef PG8_LDA
#undef PG8_LDB
#undef PG8_MMA
#undef PG8_WAIT_V
#undef PG8_WAIT_L
#undef PG8_BAR
#undef PG8_SCHED
}
}
#define GAS __attribute__((address_space(1)))
#define LAS __attribute__((address_space(3)))
typedef unsigned short bf16;
typedef unsigned v4u __attribute__((ext_vector_type(4)));
typedef float f32x4 __attribute__((ext_vector_type(4)));
typedef short bf16x8 __attribute__((ext_vector_type(8)));
typedef GAS unsigned gu32;
typedef GAS unsigned long long gu64;
#define RLX_AGENT __ATOMIC_RELAXED, __HIP_MEMORY_SCOPE_AGENT
#define LDS_WAIT() asm volatile("s_waitcnt lgkmcnt(0)" ::: "memory")
#define VM_WAIT() asm volatile("s_waitcnt vmcnt(0)" ::: "memory")
__device__ __forceinline__ unsigned long long rt() { return __builtin_amdgcn_s_memrealtime(); }
__device__ __forceinline__ unsigned f2bf(float f) { unsigned u = __builtin_bit_cast(unsigned, f); return (u + 0x7fffu + ((u >> 16) & 1u)) >> 16; }
__device__ __forceinline__ unsigned pk2(float lo, float hi) { return f2bf(lo) | (f2bf(hi) << 16); }

#define XB_TMO      128
#define XB_XCNT(j)  (256  + 64 * (j))
#define XB_XSUB(j)  (1280 + 64 * (j))
#define XB_XGEN(j)  (2304 + 64 * (j))
#define XB_TOP      3328
#define XB_TOPGEN   3392
#define XCD_BAR_WORDS 3456
#define XB_SPIN_CAP (1u << 24)

__device__ __forceinline__ unsigned xb_ld(unsigned* p)              { return __hip_atomic_load(p, __ATOMIC_RELAXED, __HIP_MEMORY_SCOPE_AGENT); }
__device__ __forceinline__ unsigned xb_add(unsigned* p, unsigned v) { return __hip_atomic_fetch_add(p, v, __ATOMIC_RELAXED, __HIP_MEMORY_SCOPE_AGENT); }
__device__ __forceinline__ unsigned xb_xcc_id() { return (unsigned)__builtin_amdgcn_s_getreg((3 << 11) | 20) & 0xFu; }
#define XB_SPIN(cond, bar) do { unsigned _sp = 0; while (cond) { __builtin_amdgcn_s_sleep(1); \
    if ((++_sp & 255u) == 0u) { if (xb_ld(&(bar)[XB_TMO])) break; if (_sp > XB_SPIN_CAP) { atomicAdd(&(bar)[XB_TMO], 1u); break; } } } } while (0)

struct XcdBarrier {
    unsigned* bar; unsigned x;
    volatile LAS unsigned* st;
};

__device__ __forceinline__ XcdBarrier xcd_barrier_post(unsigned* bar, volatile LAS unsigned* st) {
    XcdBarrier b; b.bar = bar; b.x = xb_xcc_id(); b.st = st;
    if (threadIdx.x == 0) (void)xb_add(&bar[XB_XCNT(b.x)], 1u);
    return b;
}
__device__ __forceinline__ void xcd_barrier_complete(unsigned* bar, unsigned x, unsigned& nloc, unsigned& nx) {
    const unsigned G = gridDim.x * gridDim.y * gridDim.z;
    unsigned sum, cnt, mine, sp = 0u;
    for (;;) {
        sum = 0u; cnt = 0u; mine = 0u;
#pragma unroll
        for (unsigned j = 0; j < 16; ++j) { const unsigned c = xb_ld(&bar[XB_XCNT(j)]); sum += c; cnt += (c > 0u) ? 1u : 0u; mine = (j == x) ? c : mine; }
        if (sum == G) break;
        __builtin_amdgcn_s_sleep(1);
        if ((++sp & 255u) == 0u) { if (xb_ld(&bar[XB_TMO])) break; if (sp > XB_SPIN_CAP) { atomicAdd(&bar[XB_TMO], 1u); break; } }
    }
    nloc = mine > 0u ? mine : 1u; nx = cnt > 0u ? cnt : 1u;
}

__device__ __forceinline__ void xcd_barrier(const XcdBarrier& b) {
    asm volatile("s_waitcnt vmcnt(0)" ::: "memory");
    __syncthreads();
    if (threadIdx.x == 0) {
        unsigned* bar = b.bar;
        __builtin_amdgcn_s_waitcnt(0);
        unsigned nloc = b.st[0], nx = b.st[1];
        if (nloc == 0u) { xcd_barrier_complete(bar, b.x, nloc, nx); b.st[0] = nloc; b.st[1] = nx; }
        const unsigned old = xb_add(&bar[XB_XSUB(b.x)], 1u);
        const unsigned gen = old / nloc;
        if (old + 1u == (gen + 1u) * nloc) {
            __builtin_amdgcn_fence(__ATOMIC_RELEASE, "agent");
            asm volatile("s_waitcnt vmcnt(0)" ::: "memory");
            const unsigned og = xb_add(&bar[XB_TOP], 1u);
            const unsigned tg = og / nx;
            if (og + 1u == (tg + 1u) * nx) xb_add(&bar[XB_TOPGEN], 1u);
            else XB_SPIN(xb_ld(&bar[XB_TOPGEN]) == tg, bar);
            __builtin_amdgcn_fence(__ATOMIC_ACQUIRE, "agent");
            xb_add(&bar[XB_XGEN(b.x)], 1u);
            asm volatile("s_waitcnt vmcnt(0)" ::: "memory");
        } else {
            XB_SPIN(xb_ld(&bar[XB_XGEN(b.x)]) == gen, bar);
            __builtin_amdgcn_fence(__ATOMIC_ACQUIRE, "agent");
            asm volatile("s_waitcnt vmcnt(0)" ::: "memory");
        }
    }
    __syncthreads();
}

constexpr int NWAVES = 8;
constexpr int BATCH = 2, SEQ = 16384, DM = 2048, T = BATCH * SEQ;
constexpr int GH = 4, GDK = 128, GDV = 256, GWK = 512, GWV = 1024, GRANK = 16;
constexpr int MH = 8, MDH = 128, MW = 1024, MBLK = 256, NBLK = SEQ / MBLK;
constexpr int NSRC = 11280;
constexpr int NPA = 5120, NPB = 6144;
constexpr int NP = 11520;
constexpr float NORM_EPS = 1e-6f;
constexpr int A_GQ = 0, A_GK = 512, A_GV = 1024, A_MQ = 2048, A_MK = 3072, A_MV = 4096;
constexpr int B_GS = 0, B_MS = 1024, B_GA = 2048, B_GB = 4096;

constexpr size_t MiB = 1u << 20;
constexpr size_t WS_CTL = 0, CTL_ZERO_BYTES = 1 * MiB;
constexpr size_t WS_KMEAN = 1 * MiB;
constexpr size_t WS_WIN = 2 * MiB;
constexpr size_t WS_WCAT = 47 * MiB;
constexpr size_t WS_WOUT = 55 * MiB;
constexpr size_t WS_GLR = 63 * MiB;
constexpr size_t WS_SEL = 65 * MiB;
constexpr size_t WS_XN = 70 * MiB;
constexpr size_t WS_ACAT = WS_XN;
constexpr size_t WS_PA = 198 * MiB;
constexpr size_t WS_MG = WS_PA;
constexpr size_t WS_PB = 518 * MiB;
constexpr size_t WS_END = 902 * MiB;

constexpr int CW_BAR = 4096;

constexpr int RING_OFF = 0, RING_BYTES = 131072;
constexpr int LDSCTL_OFF = RING_BYTES, MISC_OFF = LDSCTL_OFF + 320;
constexpr int LDS_BYTES = 147456;

__device__ __forceinline__ float bflo(unsigned u) { return __builtin_bit_cast(float, u << 16); }
__device__ __forceinline__ float bfhi(unsigned u) { return __builtin_bit_cast(float, u & 0xffff0000u); }
__device__ __forceinline__ float bf2f(unsigned short u) { return __builtin_bit_cast(float, (unsigned)u << 16); }
__device__ __forceinline__ float sigmoidf_(float v) { return __builtin_amdgcn_rcpf(1.0f + __builtin_amdgcn_exp2f(-1.44269504089f * v)); }
__device__ __forceinline__ float wave_sum(float v) {
#pragma unroll
    for (int o = 1; o < 64; o <<= 1) v += __shfl_xor(v, o);
    return v;
}
__device__ __forceinline__ float wave_max(float v) {
#pragma unroll
    for (int o = 1; o < 64; o <<= 1) v = fmaxf(v, __shfl_xor(v, o));
    return v;
}

namespace pg8 {
struct EpiProj {
    static constexpr bool PERM = true, AFTER_DRAIN = false, MID_HOOK = false;
    bf16_t* PA; bf16_t* PB; float* GLR;
    __device__ __forceinline__ void operator()(const f32x4 (&acc)[2][2][4][2], const Unit& u, int wr, int wc, int fr, int fq) const {
        const int pn = u.pn, row0 = u.pm * BM + wr * 64 + fr;
        if (pn < 20) {
            const float sc = pn < 2 ? 0.08838834764831845f : 1.0f;
            const int col0 = pn * BM + wc * 32 + 8 * fq;
#pragma unroll
            for (int ai = 0; ai < 2; ++ai)
#pragma unroll
                for (int m = 0; m < 4; ++m) { bf16_t* rowp = PA + (size_t)(row0 + ai * HALF + m * 16) * NPA + col0;
#pragma unroll
                    for (int bj = 0; bj < 2; ++bj) { const f32x4 v0 = acc[ai][bj][m][0] * sc, v1 = acc[ai][bj][m][1] * sc;
                        u32x4 w; w.x = cvt_pk_bf16(v0[0], v0[1]); w.y = cvt_pk_bf16(v0[2], v0[3]); w.z = cvt_pk_bf16(v1[0], v1[1]); w.w = cvt_pk_bf16(v1[2], v1[3]);
                        *(u32x4*)(rowp + bj * HALF) = w; } }
        } else if (pn < 44) {
            const bool is_silu = pn < 28;
            const int col0 = (pn - 20) * BM + wc * 32 + 8 * fq;
#pragma unroll
            for (int ai = 0; ai < 2; ++ai)
#pragma unroll
                for (int m = 0; m < 4; ++m) { bf16_t* rowp = PB + (size_t)(row0 + ai * HALF + m * 16) * NPB + col0;
#pragma unroll
                    for (int bj = 0; bj < 2; ++bj) { float v[8];
#pragma unroll
                        for (int i = 0; i < 4; ++i) { v[i] = acc[ai][bj][m][0][i]; v[4 + i] = acc[ai][bj][m][1][i]; }
#pragma unroll
                        for (int i = 0; i < 8; ++i) { const float s = sigmoidf_(v[i]); v[i] = is_silu ? v[i] * s : s; }
                        u32x4 w; w.x = cvt_pk_bf16(v[0], v[1]); w.y = cvt_pk_bf16(v[2], v[3]); w.z = cvt_pk_bf16(v[4], v[5]); w.w = cvt_pk_bf16(v[6], v[7]);
                        *(u32x4*)(rowp + bj * HALF) = w; } }
        } else {
            if (wc == 0 && fq < 2) {
#pragma unroll
                for (int ai = 0; ai < 2; ++ai)
#pragma unroll
                    for (int m = 0; m < 4; ++m) { float* rowp = GLR + (size_t)(row0 + ai * HALF + m * 16) * 16 + 8 * fq;
                        *(f32x4*)(rowp) = acc[ai][0][m][0]; *(f32x4*)(rowp + 4) = acc[ai][0][m][1]; }
            }
        }
    }
};
struct EpiMerge {
    static constexpr bool PERM = true, AFTER_DRAIN = false, MID_HOOK = true;
    const bf16_t* PB; bf16_t* MG;
    __device__ __forceinline__ void mid(f32x4 (&acc)[2][2][4][2], const Unit& u, int wr, int wc, int fr, int fq) const {
        int opq; asm volatile("v_mov_b32 %0, 0" : "=v"(opq));
        const int row0 = u.pm * BM + wr * 64 + fr + opq, col0 = u.pn * BM + wc * 32 + 8 * fq;
#pragma unroll
        for (int ai = 0; ai < 2; ++ai)
#pragma unroll
            for (int m = 0; m < 4; ++m) { const bf16_t* rowp = PB + (size_t)(row0 + ai * HALF + m * 16) * NPB + col0;
#pragma unroll
                for (int bj = 0; bj < 2; ++bj) {
                    const u32x4 a = *(const u32x4*)(rowp + B_GA + bj * HALF), b = *(const u32x4*)(rowp + B_GB + bj * HALF);
                    f32x4 r0, r1;
                    r0[0] = bflo(a.x) * __builtin_amdgcn_rcpf(bflo(b.x)); r0[1] = bfhi(a.x) * __builtin_amdgcn_rcpf(bfhi(b.x));
                    r0[2] = bflo(a.y) * __builtin_amdgcn_rcpf(bflo(b.y)); r0[3] = bfhi(a.y) * __builtin_amdgcn_rcpf(bfhi(b.y));
                    r1[0] = bflo(a.z) * __builtin_amdgcn_rcpf(bflo(b.z)); r1[1] = bfhi(a.z) * __builtin_amdgcn_rcpf(bfhi(b.z));
                    r1[2] = bflo(a.w) * __builtin_amdgcn_rcpf(bflo(b.w)); r1[3] = bfhi(a.w) * __builtin_amdgcn_rcpf(bfhi(b.w));
                    acc[ai][bj][m][0] = acc[ai][bj][m][0] * r0; acc[ai][bj][m][1] = acc[ai][bj][m][1] * r1; }
                __builtin_amdgcn_sched_barrier(0); }
    }
    __device__ __forceinline__ void operator()(const f32x4 (&acc)[2][2][4][2], const Unit& u, int wr, int wc, int fr, int fq) const {
        const int row0 = u.pm * BM + wr * 64 + fr, col0 = u.pn * BM + wc * 32 + 8 * fq;
#pragma unroll
        for (int ai = 0; ai < 2; ++ai)
#pragma unroll
            for (int m = 0; m < 4; ++m) { const size_t row = (size_t)(row0 + ai * HALF + m * 16); const bf16_t* gp = PB + row * NPB + B_GB + col0; bf16_t* op = MG + row * DM + col0;
#pragma unroll
                for (int bj = 0; bj < 2; ++bj) { const u32x4 b = *(const u32x4*)(gp + bj * HALF);
                    const f32x4 v0 = acc[ai][bj][m][0], v1 = acc[ai][bj][m][1];
                    u32x4 w; w.x = cvt_pk_bf16(v0[0] * bflo(b.x), v0[1] * bfhi(b.x)); w.y = cvt_pk_bf16(v0[2] * bflo(b.y), v0[3] * bfhi(b.y));
                    w.z = cvt_pk_bf16(v1[0] * bflo(b.z), v1[1] * bfhi(b.z)); w.w = cvt_pk_bf16(v1[2] * bflo(b.w), v1[3] * bfhi(b.w));
                    *(u32x4*)(op + bj * HALF) = w; } }
    }
};
struct EpiOut {
    static constexpr bool PERM = true, AFTER_DRAIN = false, MID_HOOK = false;
    const float* X; float* O;
    __device__ __forceinline__ void operator()(const f32x4 (&acc)[2][2][4][2], const Unit& u, int wr, int wc, int fr, int fq) const {
        const int row0 = u.pm * BM + wr * 64 + fr, col0 = u.pn * BM + wc * 32 + 8 * fq;
#pragma unroll
        for (int ai = 0; ai < 2; ++ai)
#pragma unroll
            for (int m = 0; m < 4; ++m) { const size_t off = (size_t)(row0 + ai * HALF + m * 16) * DM + col0;
#pragma unroll
                for (int bj = 0; bj < 2; ++bj) { const float* xp = X + off + bj * HALF; float* op = O + off + bj * HALF;
                    const f32x4 x0 = *(const f32x4*)xp, x1 = *(const f32x4*)(xp + 4);
                    *(f32x4*)op = x0 + acc[ai][bj][m][0]; *(f32x4*)(op + 4) = x1 + acc[ai][bj][m][1]; } }
    }
};
}

struct Frame {
    LAS unsigned char* lds;
    int tid, lane, wave, vcu, G;
    const float *x, *norm_g, *w_in, *w_gate, *b_gate, *gla_g, *qn_g, *kn_g, *w_bg, *w_bm, *w_out;
    float* out;
    bf16 *WIN, *WCAT, *WOUT, *XN, *ACAT, *PA, *PB, *MG;
    float *GLR, *KMEAN, *OG;
    int* SEL;
};

__device__ __forceinline__ int win_src_col(int d) {
    if (d < 2048) return d;
    if (d < 5120) return d - 2048 + 3088;
    if (d < 6144) return d - 5120 + 2064;
    if (d < 7168) return d - 6144 + 6160;
    if (d < 11264) return d - 7168 + 7184;
    if (d < 11280) return d - 11264 + 2048;
    return -1;
}
template <bool MAPPED>
__device__ __forceinline__ void transpose_item(const float* W, int Nsrc, bf16* WT, int ldk, int koff, int k0, int n0, LAS float* scr, int lane) {
    const int nn = n0 + (lane & 31);
    const int sc = MAPPED ? win_src_col(nn) : nn;
#pragma unroll 8
    for (int i = 0; i < 32; ++i) { const int kk = 2 * i + (lane >> 5); scr[kk * 33 + (lane & 31)] = sc >= 0 ? W[(size_t)(k0 + kk) * Nsrc + sc] : 0.f; }
    LDS_WAIT(); asm volatile("" ::: "memory");
    const int c = lane & 7;
#pragma unroll
    for (int j = 0; j < 4; ++j) { const int n = (lane >> 3) + 8 * j; const LAS float* s = scr + (8 * c) * 33 + n;
        v4u o; o.x = pk2(s[0 * 33], s[1 * 33]); o.y = pk2(s[2 * 33], s[3 * 33]); o.z = pk2(s[4 * 33], s[5 * 33]); o.w = pk2(s[6 * 33], s[7 * 33]);
        *(GAS v4u*)(WT + (size_t)(n0 + n) * ldk + koff + k0 + 8 * c) = o; }
    LDS_WAIT(); asm volatile("" ::: "memory");
}
__device__ __forceinline__ void p0_prologue(Frame& F) {
    LAS float* scr = (LAS float*)(F.lds + RING_OFF + F.wave * 16384);
    const int gw = F.vcu * NWAVES + F.wave, NGW = F.G * NWAVES;
    constexpr int NB_IN = 11296 / 32, I_IN = (DM / 64) * NB_IN;
    constexpr int I_BG = (1024 / 64) * (DM / 32), I_OUT = (DM / 64) * (DM / 32);
    constexpr int NITEMS = I_IN + 2 * I_BG + I_OUT;
    for (int it = gw; it < NITEMS; it += NGW) {
        int r = it;
        if (r < I_IN) { const int kb = r / NB_IN, nb = r % NB_IN; transpose_item<true>(F.w_in, NSRC, F.WIN, DM, 0, 64 * kb, 32 * nb, scr, F.lane); continue; } r -= I_IN;
        if (r < I_BG) { const int kb = r / (DM / 32), nb = r % (DM / 32); transpose_item<false>(F.w_bg, DM, F.WCAT, 2048, 0, 64 * kb, 32 * nb, scr, F.lane); continue; } r -= I_BG;
        if (r < I_BG) { const int kb = r / (DM / 32), nb = r % (DM / 32); transpose_item<false>(F.w_bm, DM, F.WCAT, 2048, 1024, 64 * kb, 32 * nb, scr, F.lane); continue; } r -= I_BG;
        { const int kb = r / (DM / 32), nb = r % (DM / 32); transpose_item<false>(F.w_out, DM, F.WOUT, DM, 0, 64 * kb, 32 * nb, scr, F.lane); }
    }
    f32x4 g[8];
#pragma unroll
    for (int j = 0; j < 8; ++j) g[j] = ((const GAS f32x4*)F.norm_g)[64 * j + F.lane];
    for (int m = gw; m < T; m += NGW) {
        const GAS f32x4* xr = (const GAS f32x4*)(F.x + (size_t)m * DM) + F.lane;
        f32x4 v[8]; float s = 0.f;
#pragma unroll
        for (int j = 0; j < 8; ++j) { v[j] = xr[64 * j]; s += (v[j].x * v[j].x + v[j].y * v[j].y) + (v[j].z * v[j].z + v[j].w * v[j].w); }
        const float r = 1.0f / sqrtf(wave_sum(s) * (1.0f / DM) + NORM_EPS);
        GAS unsigned long long* o8 = (GAS unsigned long long*)(F.XN + (size_t)m * DM) + F.lane;
#pragma unroll
        for (int j = 0; j < 8; ++j) { const f32x4 y = v[j] * r * g[j]; o8[64 * j] = (unsigned long long)pk2(y.x, y.y) | ((unsigned long long)pk2(y.z, y.w) << 32); }
    }
}

__device__ __forceinline__ void m0_qknorm(Frame& F) {
    LAS float* red = (LAS float*)(F.lds);
    const int rg = F.tid >> 4, l16 = F.tid & 15;
    for (int item = F.vcu; item < BATCH * NBLK * MH; item += F.G) {
        const int h = item % MH, blk = (item / MH) % NBLK, b = item / (MH * NBLK);
        float gq[8], gk[8], cs[8];
#pragma unroll
        for (int e = 0; e < 8; ++e) { gq[e] = F.qn_g[l16 * 8 + e]; gk[e] = F.kn_g[l16 * 8 + e]; cs[e] = 0.f; }
        for (int it = 0; it < 8; ++it) {
            const size_t row = (size_t)b * SEQ + blk * MBLK + it * 32 + rg;
#pragma unroll
            for (int w = 0; w < 2; ++w) {
                bf16* p = F.PA + row * NPA + (w ? A_MK : A_MQ) + h * MDH + l16 * 8;
                const v4u raw = *(const GAS v4u*)p; float v[8];
                v[0] = bflo(raw.x); v[1] = bfhi(raw.x); v[2] = bflo(raw.y); v[3] = bfhi(raw.y); v[4] = bflo(raw.z); v[5] = bfhi(raw.z); v[6] = bflo(raw.w); v[7] = bfhi(raw.w);
                float ss = 0.f;
#pragma unroll
                for (int e = 0; e < 8; ++e) ss += v[e] * v[e];
                ss += __shfl_xor(ss, 1); ss += __shfl_xor(ss, 2); ss += __shfl_xor(ss, 4); ss += __shfl_xor(ss, 8);
                const float r = 1.0f / sqrtf(ss * (1.0f / MDH) + NORM_EPS);
#pragma unroll
                for (int e = 0; e < 8; ++e) { v[e] = v[e] * r * (w ? gk[e] : gq[e]); if (w) cs[e] += v[e]; }
                v4u o; o.x = pk2(v[0], v[1]); o.y = pk2(v[2], v[3]); o.z = pk2(v[4], v[5]); o.w = pk2(v[6], v[7]);
                *(GAS v4u*)p = o;
            }
        }
#pragma unroll
        for (int e = 0; e < 8; ++e) red[rg * 128 + l16 * 8 + e] = cs[e];
        __syncthreads();
        if (F.tid < 128) { float s = 0.f;
#pragma unroll 8
            for (int r = 0; r < 32; ++r) s += red[r * 128 + F.tid];
            F.KMEAN[((size_t)(b * MH + h) * NBLK + blk) * MDH + F.tid] = s * (1.0f / MBLK); }
        __syncthreads();
    }
}

__device__ __forceinline__ void m1_select(Frame& F) {
    LAS float* km = (LAS float*)(F.lds);
    for (int item = F.vcu; item < BATCH * MH * (SEQ / 512); item += F.G) {
        const int qc = item % (SEQ / 512), h = (item / (SEQ / 512)) % MH, b = item / ((SEQ / 512) * MH);
        __syncthreads();
        for (int i = F.tid; i < NBLK * MDH; i += NWAVES * 64) { const int j = i / MDH, d = i % MDH; km[d * NBLK + j] = F.KMEAN[(size_t)(b * MH + h) * NBLK * MDH + i]; }
        __syncthreads();
        const int t = qc * 512 + F.tid, qb = t / MBLK;
        const bf16* qp = F.PA + ((size_t)b * SEQ + t) * NPA + A_MQ + h * MDH;
        float acc[NBLK];
#pragma unroll
        for (int j = 0; j < NBLK; ++j) acc[j] = 0.f;
        for (int c = 0; c < 16; ++c) {
            const v4u raw = *(const GAS v4u*)(qp + c * 8); float q[8];
            q[0] = bflo(raw.x); q[1] = bfhi(raw.x); q[2] = bflo(raw.y); q[3] = bfhi(raw.y); q[4] = bflo(raw.z); q[5] = bfhi(raw.z); q[6] = bflo(raw.w); q[7] = bfhi(raw.w);
#pragma unroll
            for (int e = 0; e < 8; ++e) { const LAS f32x4* kr = (const LAS f32x4*)(km + (c * 8 + e) * NBLK);
#pragma unroll
                for (int j4 = 0; j4 < NBLK / 4; ++j4) { const f32x4 kv = kr[j4];
                    acc[4 * j4 + 0] = fmaf(q[e], kv.x, acc[4 * j4 + 0]); acc[4 * j4 + 1] = fmaf(q[e], kv.y, acc[4 * j4 + 1]);
                    acc[4 * j4 + 2] = fmaf(q[e], kv.z, acc[4 * j4 + 2]); acc[4 * j4 + 3] = fmaf(q[e], kv.w, acc[4 * j4 + 3]); } }
        }
        unsigned long long taken = 0ull; int sel[4] = {-1, -1, -1, -1};
#pragma unroll
        for (int r = 0; r < 3; ++r) {
            float best = -3.0e38f; int bi = -1;
#pragma unroll
            for (int j = 0; j < NBLK; ++j) { const bool ok = (j < qb) && !((taken >> j) & 1ull) && (acc[j] > best); best = ok ? acc[j] : best; bi = ok ? j : bi; }
            sel[r] = bi; if (bi >= 0) taken |= (1ull << bi);
        }
        int4 o; o.x = sel[0]; o.y = sel[1]; o.z = sel[2]; o.w = -1;
        *(int4*)(F.SEL + (((size_t)(b * MH + h) * SEQ + t) * 4)) = o;
    }
}

__device__ __forceinline__ void m2_attn_naive(Frame& F) {
    LAS float* P = (LAS float*)(F.lds) + F.wave * 1024;
    const int gw = F.vcu * NWAVES + F.wave, NGW = F.G * NWAVES;
    for (int item = gw; item < BATCH * MH * SEQ; item += NGW) {
        const int t = item % SEQ, h = (item / SEQ) % MH, b = item / (SEQ * MH);
        const int own = t / MBLK;
        const int4 s4 = *(const int4*)(F.SEL + (((size_t)(b * MH + h) * SEQ + t) * 4));
        unsigned blks = 0u; int nb = 0;
        if (s4.x >= 0) { blks |= (unsigned)s4.x << (8 * nb); ++nb; } if (s4.y >= 0) { blks |= (unsigned)s4.y << (8 * nb); ++nb; } if (s4.z >= 0) { blks |= (unsigned)s4.z << (8 * nb); ++nb; }
        blks |= (unsigned)own << (8 * nb); ++nb;
        const float slope = __builtin_amdgcn_exp2f(-(float)(h + 1));
        const bf16* qp = F.PA + ((size_t)b * SEQ + t) * NPA + A_MQ + h * MDH;
        v4u q[16];
#pragma unroll
        for (int c = 0; c < 16; ++c) q[c] = *(const GAS v4u*)(qp + c * 8);
        float mx = -3.0e38f;
        for (int bi = 0; bi < nb; ++bi) {
            const int blk = (int)((blks >> (8 * bi)) & 0xffu);
            for (int kc = 0; kc < 4; ++kc) {
                const int pos = blk * MBLK + kc * 64 + F.lane;
                const bf16* kp = F.PA + ((size_t)b * SEQ + pos) * NPA + A_MK + h * MDH;
                float s = 0.f;
#pragma unroll
                for (int c = 0; c < 16; ++c) { const v4u kv = *(const GAS v4u*)(kp + c * 8);
                    s += bflo(kv.x) * bflo(q[c].x) + bfhi(kv.x) * bfhi(q[c].x) + bflo(kv.y) * bflo(q[c].y) + bfhi(kv.y) * bfhi(q[c].y)
                       + bflo(kv.z) * bflo(q[c].z) + bfhi(kv.z) * bfhi(q[c].z) + bflo(kv.w) * bflo(q[c].w) + bfhi(kv.w) * bfhi(q[c].w); }
                s = s * 0.08838834764831845f - slope * (float)(t - pos);
                if (pos > t) s = -1.0e30f;
                P[bi * 256 + kc * 64 + F.lane] = s; mx = fmaxf(mx, s);
            }
        }
        mx = wave_max(mx);
        float l = 0.f;
        for (int i = F.lane; i < nb * 256; i += 64) { const float p = __builtin_amdgcn_exp2f((P[i] - mx) * 1.44269504089f); P[i] = p; l += p; }
        l = wave_sum(l);
        LDS_WAIT(); asm volatile("" ::: "memory");
        float o0 = 0.f, o1 = 0.f;
        for (int bi = 0; bi < nb; ++bi) {
            const bf16* vp = F.PA + ((size_t)b * SEQ + (int)((blks >> (8 * bi)) & 0xffu) * MBLK) * NPA + A_MV + h * MDH + 2 * F.lane;
#pragma unroll 8
            for (int k = 0; k < 256; ++k) { const float p = P[bi * 256 + k]; const unsigned vv = *(const GAS unsigned*)(vp + (size_t)k * NPA); o0 = fmaf(p, bflo(vv), o0); o1 = fmaf(p, bfhi(vv), o1); }
        }
        const float inv = 1.0f / l;
        const unsigned gs = *(const GAS unsigned*)(F.PB + ((size_t)b * SEQ + t) * NPB + B_MS + h * MDH + 2 * F.lane);
        *(GAS unsigned*)(F.ACAT + ((size_t)b * SEQ + t) * 2048 + 1024 + h * MDH + 2 * F.lane) = pk2(o0 * inv * bflo(gs), o1 * inv * bfhi(gs));
        LDS_WAIT(); asm volatile("" ::: "memory");
    }
}

__device__ __forceinline__ void gla_naive(Frame& F) {
    LAS float* Wg = (LAS float*)(F.lds);
    LAS float* bg = Wg + 16 * 128;
    LAS float* glr = bg + 128;
    LAS float* aa = glr + 64 * 16;
    LAS float* qq = aa + 64 * 128;
    LAS float* kk = qq + 64 * 128;
    LAS float* vv = kk + 64 * 128;
    for (int item = F.vcu; item < BATCH * GH * (GDV / 8); item += F.G) {
        const int dvs = item % (GDV / 8), h = (item / (GDV / 8)) % GH, b = item / ((GDV / 8) * GH);
        __syncthreads();
        for (int i = F.tid; i < 16 * 128; i += 512) Wg[i] = F.w_gate[(size_t)(i / 128) * GWK + h * GDK + (i % 128)];
        if (F.tid < 128) bg[F.tid] = F.b_gate[h * GDK + F.tid];
        float S0 = 0.f, S1 = 0.f;
        const int dv = dvs * 8 + F.wave;
        for (int c0 = 0; c0 < SEQ; c0 += 64) {
            __syncthreads();
            const size_t rowb = (size_t)b * SEQ + c0;
            for (int i = F.tid; i < 64 * 16; i += 512) glr[i] = F.GLR[rowb * 16 + i];
            for (int i = F.tid; i < 64 * 128; i += 512) { const int r = i >> 7, d = i & 127; const bf16* p = F.PA + (rowb + r) * NPA + h * GDK + d; qq[i] = bf2f(p[A_GQ]); kk[i] = bf2f(p[A_GK]); }
            { const int r = F.tid >> 3, j = F.tid & 7; vv[F.tid] = bf2f(F.PA[(rowb + r) * NPA + A_GV + h * GDV + dvs * 8 + j]); }
            __syncthreads();
            for (int i = F.tid; i < 64 * 128; i += 512) { const int r = i >> 7, d = i & 127; float z = bg[d];
#pragma unroll
                for (int j = 0; j < 16; ++j) z = fmaf(glr[r * 16 + j], Wg[j * 128 + d], z);
                const float ls = fminf(z, 0.f) - log1pf(expf(-fabsf(z)));
                aa[i] = expf(ls * (1.0f / 16.0f)); }
            __syncthreads();
            for (int r = 0; r < 64; ++r) {
                const float v = vv[r * 8 + F.wave];
                S0 = aa[r * 128 + F.lane] * S0 + kk[r * 128 + F.lane] * v;
                S1 = aa[r * 128 + 64 + F.lane] * S1 + kk[r * 128 + 64 + F.lane] * v;
                const float o = wave_sum(qq[r * 128 + F.lane] * S0 + qq[r * 128 + 64 + F.lane] * S1);
                if (F.lane == 0) F.OG[(rowb + r) * GWV + h * GDV + dv] = o;
            }
        }
    }
}
__device__ __forceinline__ void gla_post(Frame& F) {
    const int gw = F.vcu * NWAVES + F.wave, NGW = F.G * NWAVES;
    const f32x4 g = ((const GAS f32x4*)F.gla_g)[F.lane];
    for (int item = gw; item < T * GH; item += NGW) {
        const int h = item % GH; const size_t row = item / GH;
        const f32x4 o = ((const GAS f32x4*)(F.OG + row * GWV + h * GDV))[F.lane];
        const float ss = wave_sum((o.x * o.x + o.y * o.y) + (o.z * o.z + o.w * o.w));
        const float r = 1.0f / sqrtf(ss * (1.0f / GDV) + NORM_EPS);
        const unsigned long long gs = *(const GAS unsigned long long*)(F.PB + row * NPB + B_GS + h * GDV + 4 * F.lane);
        const unsigned lo = (unsigned)gs, hi = (unsigned)(gs >> 32);
        const unsigned long long w = (unsigned long long)pk2(o.x * r * g.x * bflo(lo), o.y * r * g.y * bfhi(lo)) | ((unsigned long long)pk2(o.z * r * g.z * bflo(hi), o.w * r * g.w * bfhi(hi)) << 32);
        *(GAS unsigned long long*)(F.ACAT + row * 2048 + h * GDV + 4 * F.lane) = w;
    }
}

constexpr int N_PHASES = 9;
#ifndef MK_N_LAUNCHES
#define MK_N_LAUNCHES 9
#endif
struct Args { const float* in[11]; float* out; unsigned char* ws; int ph_lo, ph_hi; };
__global__ void __launch_bounds__(NWAVES * 64, 2) mk_fwd(Args args) {
    extern __shared__ __attribute__((aligned(16))) unsigned char lds[];
    Frame F;
    F.lds = (LAS unsigned char*)lds;
    F.tid = threadIdx.x; F.lane = F.tid & 63; F.wave = __builtin_amdgcn_readfirstlane(F.tid >> 6);
    F.G = gridDim.x; { const int bx = blockIdx.x; F.vcu = (F.G % 8 == 0) ? (bx % 8) * (F.G / 8) + bx / 8 : bx; }
    unsigned char* ws = args.ws;
    F.x = args.in[0]; F.norm_g = args.in[1]; F.w_in = args.in[2]; F.w_gate = args.in[3]; F.b_gate = args.in[4]; F.gla_g = args.in[5];
    F.qn_g = args.in[6]; F.kn_g = args.in[7]; F.w_bg = args.in[8]; F.w_bm = args.in[9]; F.w_out = args.in[10]; F.out = args.out;
    F.WIN = (bf16*)(ws + WS_WIN); F.WCAT = (bf16*)(ws + WS_WCAT); F.WOUT = (bf16*)(ws + WS_WOUT); F.XN = (bf16*)(ws + WS_XN); F.ACAT = (bf16*)(ws + WS_ACAT);
    F.PA = (bf16*)(ws + WS_PA); F.PB = (bf16*)(ws + WS_PB); F.MG = (bf16*)(ws + WS_MG);
    F.GLR = (float*)(ws + WS_GLR); F.KMEAN = (float*)(ws + WS_KMEAN); F.OG = args.out; F.SEL = (int*)(ws + WS_SEL);
    volatile LAS unsigned* MISC = (volatile LAS unsigned*)(F.lds + MISC_OFF);
    for (int u = F.tid; u < (LDS_BYTES - LDSCTL_OFF) / 4; u += NWAVES * 64) ((LAS unsigned*)(F.lds + LDSCTL_OFF))[u] = 0u;
    __syncthreads();
    const int lo = args.ph_lo, hi = args.ph_hi;
    XcdBarrier bar; bar.bar = (unsigned*)(ws + WS_CTL) + CW_BAR; bar.x = 0; bar.st = nullptr;
    if (hi - lo > 1) bar = xcd_barrier_post((unsigned*)(ws + WS_CTL) + CW_BAR, MISC + 8);
#ifndef PH_MASK
#define PH_MASK 0x1ff
#endif
#define IN(k) (((PH_MASK >> (k)) & 1) && lo <= (k) && (k) < hi)
#define SEAM(k) do { if (IN(k) && IN((k) + 1)) xcd_barrier(bar); } while (0)

    if (IN(0)) { p0_prologue(F); } SEAM(0);
    if (IN(1)) {
        pg8::Gemm g{F.XN, F.WIN, T, NP, DM}; pg8::StaticOrder S; S.init(T, NP, F.G, (int)blockIdx.x);
        pg8::EpiProj E{F.PA, F.PB, F.GLR};
        pg8::gemm_phase<pg8::EpiProj, pg8::StaticOrder, true, true>(F.lds + RING_OFF, g, S, E);
    } SEAM(1);
    if (IN(2)) { m0_qknorm(F); } SEAM(2);
    if (IN(3)) { m1_select(F); } SEAM(3);
    if (IN(4)) { m2_attn_naive(F); } SEAM(4);
    if (IN(5)) { gla_naive(F); } SEAM(5);
    if (IN(6)) { gla_post(F); } SEAM(6);
    if (IN(7)) {
        pg8::Gemm g{F.ACAT, F.WCAT, T, DM, 2048}; pg8::StaticOrder S; S.init(T, DM, F.G, (int)blockIdx.x);
        pg8::EpiMerge E{F.PB, F.MG};
        pg8::gemm_phase<pg8::EpiMerge, pg8::StaticOrder, true, true>(F.lds + RING_OFF, g, S, E);
    } SEAM(7);
    if (IN(8)) {
        pg8::Gemm g{F.MG, F.WOUT, T, DM, DM}; pg8::StaticOrder S; S.init(T, DM, F.G, (int)blockIdx.x);
        pg8::EpiOut E{F.x, F.out};
        pg8::gemm_phase<pg8::EpiOut, pg8::StaticOrder, true, true>(F.lds + RING_OFF, g, S, E);
    }
#undef IN
#undef SEAM
}

extern "C" void kernel_launch(void* const* d_in, const int* in_sizes, int n_in, void* d_out, int out_size, void* d_ws, size_t ws_size, hipStream_t stream) {
    static int grid = 0;
    if (grid == 0) {
        if (n_in != 11 || in_sizes[0] != T * DM || out_size != T * DM || ws_size < WS_END) { fprintf(stderr, "kernel_launch: unexpected shapes (n_in %d, in0 %d, out %d, ws %zu)\n", n_in, n_in > 0 ? in_sizes[0] : -1, out_size, ws_size); grid = -1; return; }
        int dev = 0, cus = 0, per_cu = 0;
        if (hipGetDevice(&dev) != hipSuccess || hipDeviceGetAttribute(&cus, hipDeviceAttributeMultiprocessorCount, dev) != hipSuccess) { grid = -1; return; }
        if (hipFuncSetAttribute((const void*)mk_fwd, hipFuncAttributeMaxDynamicSharedMemorySize, LDS_BYTES) != hipSuccess) { fprintf(stderr, "kernel_launch: hipFuncSetAttribute failed\n"); grid = -1; return; }
        if (hipOccupancyMaxActiveBlocksPerMultiprocessor(&per_cu, (const void*)mk_fwd, NWAVES * 64, LDS_BYTES) != hipSuccess || per_cu < 1) { fprintf(stderr, "kernel_launch: occupancy query says %d blocks per CU\n", per_cu); per_cu = 1; }
        (void)hipGetLastError();
        grid = cus;
    }
    if (grid < 0) return;
    (void)hipMemsetAsync((char*)d_ws + WS_CTL, 0, CTL_ZERO_BYTES, stream);
    Args a{};
    for (int i = 0; i < 11; ++i) a.in[i] = (const float*)d_in[i];
    a.out = (float*)d_out; a.ws = (unsigned char*)d_ws;
    constexpr int NL = MK_N_LAUNCHES;
    for (int li = 0; li < NL; ++li) {
        a.ph_lo = (NL == 1) ? 0 : li; a.ph_hi = (NL == 1) ? N_PHASES : li + 1;
        hipLaunchKernelGGL(mk_fwd, dim3(grid), dim3(NWAVES * 64), LDS_BYTES, stream, a);
    }
}
```

```cpp
#include <hip/hip_runtime.h>
#include <cstdio>
#include <cstdint>
namespace pg8 {
#define PG8_LAS __attribute__((address_space(3)))
typedef unsigned short bf16_t;
typedef short bf16x8 __attribute__((ext_vector_type(8)));
typedef float f32x4 __attribute__((ext_vector_type(4)));
typedef unsigned u32x4 __attribute__((ext_vector_type(4)));
constexpr int BM = 256, BK = 64, HALF = 128, HTB = HALF * BK * 2  , STAGE_BYTES = 8 * HTB, NXCD = 8, WGM = 8;

__host__ __device__ __forceinline__ int lds_byte(int r, int c) { const int st = (r >> 4) * 2 + (c >> 5), rr = r & 15, cc = c & 31, ob = rr * 64 + cc * 2; return st * 1024 + (ob ^ (((ob >> 9) & 1) << 5)); }
__host__ __device__ __forceinline__ void stage_rc(int b, int& R, int& C) { const int st = b / 1024, sb = b % 1024, swz = sb ^ (((sb >> 9) & 1) << 5); R = (st >> 1) * 16 + swz / 64; C = (st & 1) * 32 + (swz % 64) / 2; }
__host__ __device__ __forceinline__ int perm32(int rho) { const int n = rho >> 4, i = rho & 15; return 8 * (i >> 2) + 4 * n + (i & 3); }

struct Unit { int pm, pn; };
struct Gemm { const bf16_t* A; const bf16_t* Bt; int M, N, K; };

struct StaticOrder {
    int nM, nN, nwg, G, c;
    __host__ __device__ void init(int M, int N, int G_, int c_) { nM = M / BM; nN = N / BM; nwg = nM * nN; G = G_; c = c_; }
    __host__ __device__ bool next(int i, Unit& u) const {
        const long L = (long)i * G + c; if (L >= nwg) return false;
        int wgid = (int)L; { const int q = nwg / NXCD, r = nwg % NXCD, xcd = wgid % NXCD, off = wgid / NXCD; wgid = (xcd < r ? xcd * (q + 1) : r * (q + 1) + (xcd - r) * q) + off; }
        const int nig = WGM * nN, gid = wgid / nig, fm = gid * WGM, gsz = (nM - fm) < WGM ? (nM - fm) : WGM;
        u.pm = fm + ((wgid % nig) % gsz); u.pn = (wgid % nig) / gsz; return true;
    }
    __device__ __forceinline__ void a_ready(const Unit&) const {}
    __device__ __forceinline__ void done(const Unit&) const {}
};

__device__ __forceinline__ unsigned cvt_pk_bf16(float lo, float hi) { unsigned r; asm volatile("v_cvt_pk_bf16_f32 %0, %1, %2" : "=v"(r) : "v"(lo), "v"(hi)); return r; }

template <class Epi, class Sched, bool ALIGN_EPI = false, bool SP2 = false>
__device__ __forceinline__ void gemm_phase(PG8_LAS unsigned char* lds, const Gemm g, const Sched& S, const Epi& E) {
    const int tid = threadIdx.x, wid = __builtin_amdgcn_readfirstlane(tid >> 6), lane = tid & 63, wr = wid >> 2, wc = wid & 3, fr = lane & 15, fq = lane >> 4;
    const int K = g.K, nt = K / BK;
    unsigned voffA[2], voffB[2];
#pragma unroll
    for (int i = 0; i < 2; ++i) { int R, C; stage_rc(tid * 16 + i * 8192, R, C); const int Rb = Epi::PERM ? ((R & ~31) + perm32(R & 31)) : R;
        voffA[i] = (unsigned)(R * K + C) * 2u; voffB[i] = (unsigned)(Rb * K + C) * 2u; }
    const size_t kstep = (size_t)(BK * 2);
    const size_t hstep = (size_t)HALF * K * 2;
    const size_t tstep = 2 * hstep;
    const unsigned ldsw = (unsigned)wid * 1024u;
    const int aoff = lds_byte(wr * 64 + fr, fq * 8), boff = lds_byte(wc * 32 + fr, fq * 8);
#define PG8_SA(b, h) (((b) * 2 + (h)) * HTB)
#define PG8_SB(b, h) ((4 + (b) * 2 + (h)) * HTB)
#define PG8_STAGE(bufoff, gbase, voff) do { _Pragma("unroll") for (int _i = 0; _i < 2; ++_i) \
        __builtin_amdgcn_global_load_lds((const unsigned*)((const char*)(gbase) + (voff)[_i]), (PG8_LAS unsigned*)(lds + (bufoff) + ldsw + _i * 8192), 16, 0, 0); } while (0)
#define PG8_LDA(dst, b, h) do { _Pragma("unroll") for (int m = 0; m < 4; ++m) _Pragma("unroll") for (int k = 0; k < 2; ++k) dst[m][k] = *(const PG8_LAS bf16x8*)(lds + PG8_SA(b, h) + aoff + m * 2048 + k * 1024); } while (0)
#define PG8_LDB(dst, b, h) do { _Pragma("unroll") for (int n = 0; n < 2; ++n) _Pragma("unroll") for (int k = 0; k < 2; ++k) dst[n][k] = *(const PG8_LAS bf16x8*)(lds + PG8_SB(b, h) + boff + n * 2048 + k * 1024); } while (0)
#define PG8_MMA(ai, bj, At, Bt) do { __builtin_amdgcn_s_setprio(1); _Pragma("unroll") for (int m = 0; m < 4; ++m) _Pragma("unroll") for (int n = 0; n < 2; ++n) _Pragma("unroll") for (int k = 0; k < 2; ++k) \
        acc[ai][bj][m][n] = __builtin_amdgcn_mfma_f32_16x16x32_bf16(Bt[n][k], At[m][k], acc[ai][bj][m][n], 0, 0, 0); __builtin_amdgcn_s_setprio(0); } while (0)
#define PG8_WAIT_V(n) asm volatile("s_waitcnt vmcnt(" #n ")" ::: "memory")
#define PG8_WAIT_L(n) asm volatile("s_waitcnt lgkmcnt(" #n ")" ::: "memory")
#define PG8_BAR __builtin_amdgcn_s_barrier()
#define PG8_SCHED __builtin_amdgcn_sched_barrier(0)
    Unit cur, nxt; int ui = 0;
    if (!S.next(0, cur)) return;
    f32x4 acc[2][2][4][2];
#pragma unroll
    for (int a = 0; a < 2; ++a)
#pragma unroll
        for (int b = 0; b < 2; ++b)
#pragma unroll
            for (int m = 0; m < 4; ++m)
#pragma unroll
                for (int n = 0; n < 2; ++n) acc[a][b][m][n] = (f32x4){0.f, 0.f, 0.f, 0.f};
    bf16x8 At[4][2], B0[2][2], B1[2][2];
    const char* cA = (const char*)g.A + (size_t)cur.pm * tstep; const char* cB = (const char*)g.Bt + (size_t)cur.pn * tstep;
    S.a_ready(cur);
    if constexpr (SP2) {
        PG8_STAGE(PG8_SB(0, 0), cB, voffB); PG8_STAGE(PG8_SB(0, 1), cB + hstep, voffB); PG8_STAGE(PG8_SA(0, 0), cA, voffA); PG8_STAGE(PG8_SA(0, 1), cA + hstep, voffA);
        if (wr == 1) PG8_BAR;
        PG8_WAIT_V(2); PG8_BAR;
        PG8_STAGE(PG8_SB(1, 0), cB + kstep, voffB); PG8_STAGE(PG8_SA(1, 0), cA + kstep, voffA); PG8_STAGE(PG8_SB(1, 1), cB + hstep + kstep, voffB);
        PG8_WAIT_V(6); PG8_BAR;
    } else {
        PG8_STAGE(PG8_SB(0, 0), cB, voffB); PG8_STAGE(PG8_SA(0, 0), cA, voffA); PG8_STAGE(PG8_SB(0, 1), cB + hstep, voffB); PG8_STAGE(PG8_SA(0, 1), cA + hstep, voffA);
        if (wr == 1) PG8_BAR;
        PG8_WAIT_V(4); PG8_BAR;
        PG8_STAGE(PG8_SB(1, 0), cB + kstep, voffB); PG8_STAGE(PG8_SA(1, 0), cA + kstep, voffA); PG8_STAGE(PG8_SB(1, 1), cB + hstep + kstep, voffB);
        PG8_WAIT_V(6); PG8_BAR;
    }
    for (;;) {
        const bool has_next = S.next(ui + 1, nxt);
        const char* nA = has_next ? (const char*)g.A + (size_t)nxt.pm * tstep : cA; const char* nB = has_next ? (const char*)g.Bt + (size_t)nxt.pn * tstep : cB;
        for (int t = 0; t < nt; t += 2) {
            if constexpr (Epi::MID_HOOK) { if (t == nt / 2) E.mid(acc, cur, wr, wc, fr, fq); }
            const bool last = (t == nt - 2);
            const char* a1 = cA + (size_t)(t + 1) * kstep;
            const char* a2 = last ? nA : cA + (size_t)(t + 2) * kstep; const char* b2 = last ? nB : cB + (size_t)(t + 2) * kstep;
            const char* a3 = a2 + kstep; const char* b3 = b2 + kstep;
            if (last && has_next) S.a_ready(nxt);
            if constexpr (SP2) {
            PG8_LDB(B0, 0, 0); PG8_LDB(B1, 0, 1); PG8_SCHED; PG8_LDA(At, 0, 0); PG8_STAGE(PG8_SA(1, 1), a1 + hstep, voffA);
            PG8_WAIT_V(8); PG8_WAIT_L(0); PG8_BAR; PG8_MMA(0, 0, At, B0); PG8_MMA(0, 1, At, B1); PG8_BAR; PG8_SCHED;
            PG8_LDA(At, 0, 1); PG8_STAGE(PG8_SB(0, 0), b2, voffB); PG8_STAGE(PG8_SB(0, 1), b2 + hstep, voffB); PG8_STAGE(PG8_SA(0, 0), a2, voffA);
            PG8_WAIT_V(8); PG8_WAIT_L(0); PG8_BAR; PG8_MMA(1, 0, At, B0); PG8_MMA(1, 1, At, B1); PG8_BAR; PG8_SCHED;
            PG8_LDB(B0, 1, 0); PG8_LDB(B1, 1, 1); PG8_SCHED; PG8_LDA(At, 1, 0); PG8_STAGE(PG8_SA(0, 1), a2 + hstep, voffA);
            PG8_WAIT_V(8); PG8_WAIT_L(0); PG8_BAR; PG8_MMA(0, 0, At, B0); PG8_MMA(0, 1, At, B1); PG8_BAR; PG8_SCHED;
            PG8_LDA(At, 1, 1); PG8_STAGE(PG8_SB(1, 0), b3, voffB); PG8_STAGE(PG8_SB(1, 1), b3 + hstep, voffB); PG8_STAGE(PG8_SA(1, 0), a3, voffA);
            PG8_WAIT_V(8); PG8_WAIT_L(0); PG8_BAR; PG8_MMA(1, 0, At, B0); PG8_MMA(1, 1, At, B1); PG8_BAR; PG8_SCHED;
            } else {
            PG8_LDB(B0, 0, 0); PG8_SCHED; PG8_LDA(At, 0, 0); PG8_STAGE(PG8_SA(1, 1), a1 + hstep, voffA);
            PG8_WAIT_L(8); PG8_BAR; PG8_WAIT_L(0); PG8_MMA(0, 0, At, B0); PG8_BAR; PG8_SCHED;
            PG8_LDB(B1, 0, 1); PG8_STAGE(PG8_SB(0, 0), b2, voffB);
            PG8_BAR; PG8_WAIT_L(0); PG8_MMA(0, 1, At, B1); PG8_BAR;
            PG8_LDA(At, 0, 1); PG8_STAGE(PG8_SA(0, 0), a2, voffA);
            PG8_BAR; PG8_WAIT_L(0); PG8_MMA(1, 0, At, B0); PG8_BAR; PG8_SCHED;
            PG8_STAGE(PG8_SB(0, 1), b2 + hstep, voffB);
            PG8_WAIT_V(6); PG8_BAR; PG8_MMA(1, 1, At, B1); PG8_BAR;
            PG8_LDB(B0, 1, 0); PG8_SCHED; PG8_LDA(At, 1, 0); PG8_STAGE(PG8_SA(0, 1), a2 + hstep, voffA);
            PG8_WAIT_L(8); PG8_BAR; PG8_WAIT_L(0); PG8_MMA(0, 0, At, B0); PG8_BAR; PG8_SCHED;
            PG8_LDB(B1, 1, 1); PG8_STAGE(PG8_SB(1, 0), b3, voffB);
            PG8_BAR; PG8_WAIT_L(0); PG8_MMA(0, 1, At, B1); PG8_BAR;
            PG8_LDA(At, 1, 1); PG8_STAGE(PG8_SA(1, 0), a3, voffA);
            PG8_BAR; PG8_WAIT_L(0); PG8_MMA(1, 0, At, B0); PG8_BAR; PG8_SCHED;
            PG8_STAGE(PG8_SB(1, 1), b3 + hstep, voffB);
            PG8_WAIT_V(6); PG8_BAR; PG8_MMA(1, 1, At, B1); PG8_BAR;
            }
        }
        if constexpr (ALIGN_EPI) { if (wr == 0) PG8_BAR; }
        if constexpr (!Epi::AFTER_DRAIN) { E(acc, cur, wr, wc, fr, fq); S.done(cur); }
        if (!has_next) break;
#pragma unroll
        for (int a = 0; a < 2; ++a)
#pragma unroll
            for (int b = 0; b < 2; ++b)
#pragma unroll
                for (int m = 0; m < 4; ++m)
#pragma unroll
                    for (int n = 0; n < 2; ++n) acc[a][b][m][n] = (f32x4){0.f, 0.f, 0.f, 0.f};
        cur = nxt; cA = nA; cB = nB; ++ui;
        if constexpr (ALIGN_EPI) { if (wr == 1) PG8_BAR; }
    }
    PG8_WAIT_V(0);
    if constexpr (!ALIGN_EPI) { if (wr == 0) PG8_BAR; }
    PG8_BAR;
    if constexpr (Epi::AFTER_DRAIN) { E.fused(acc, cur, wr, wc, fr, fq, lds, wid, lane); S.done(cur); }
#undef PG8_SA
#undef PG8_SB
#undef PG8_STAGE
#undef PG8_LDA
#undef PG8_LDB
#undef PG8_MMA
#undef PG8_WAIT_V
#undef PG8_WAIT_L
#undef PG8_BAR
#undef PG8_SCHED
}
}
#define GAS __attribute__((address_space(1)))
#define LAS __attribute__((address_space(3)))
typedef unsigned short bf16;
typedef unsigned v4u __attribute__((ext_vector_type(4)));
typedef float f32x4 __attribute__((ext_vector_type(4)));
typedef short bf16x8 __attribute__((ext_vector_type(8)));
typedef GAS unsigned gu32;
typedef GAS unsigned long long gu64;
#define RLX_AGENT __ATOMIC_RELAXED, __HIP_MEMORY_SCOPE_AGENT
#define LDS_WAIT() asm volatile("s_waitcnt lgkmcnt(0)" ::: "memory")
#define VM_WAIT() asm volatile("s_waitcnt vmcnt(0)" ::: "memory")
__device__ __forceinline__ unsigned long long rt() { return __builtin_amdgcn_s_memrealtime(); }
__device__ __forceinline__ unsigned f2bf(float f) { unsigned u = __builtin_bit_cast(unsigned, f); return (u + 0x7fffu + ((u >> 16) & 1u)) >> 16; }
__device__ __forceinline__ unsigned pk2(float lo, float hi) { return f2bf(lo) | (f2bf(hi) << 16); }

#define XB_TMO      128
#define XB_XCNT(j)  (256  + 64 * (j))
#define XB_XSUB(j)  (1280 + 64 * (j))
#define XB_XGEN(j)  (2304 + 64 * (j))
#define XB_TOP      3328
#define XB_TOPGEN   3392
#define XCD_BAR_WORDS 3456
#define XB_SPIN_CAP (1u << 24)

__device__ __forceinline__ unsigned xb_ld(unsigned* p)              { return __hip_atomic_load(p, __ATOMIC_RELAXED, __HIP_MEMORY_SCOPE_AGENT); }
__device__ __forceinline__ unsigned xb_add(unsigned* p, unsigned v) { return __hip_atomic_fetch_add(p, v, __ATOMIC_RELAXED, __HIP_MEMORY_SCOPE_AGENT); }
__device__ __forceinline__ unsigned xb_xcc_id() { return (unsigned)__builtin_amdgcn_s_getreg((3 << 11) | 20) & 0xFu; }
#define XB_SPIN(cond, bar) do { unsigned _sp = 0; while (cond) { __builtin_amdgcn_s_sleep(1); \
    if ((++_sp & 255u) == 0u) { if (xb_ld(&(bar)[XB_TMO])) break; if (_sp > XB_SPIN_CAP) { atomicAdd(&(bar)[XB_TMO], 1u); break; } } } } while (0)

struct XcdBarrier {
    unsigned* bar; unsigned x;
    volatile LAS unsigned* st;
};

__device__ __forceinline__ XcdBarrier xcd_barrier_post(unsigned* bar, volatile LAS unsigned* st) {
    XcdBarrier b; b.bar = bar; b.x = xb_xcc_id(); b.st = st;
    if (threadIdx.x == 0) (void)xb_add(&bar[XB_XCNT(b.x)], 1u);
    return b;
}
__device__ __forceinline__ void xcd_barrier_complete(unsigned* bar, unsigned x, unsigned& nloc, unsigned& nx) {
    const unsigned G = gridDim.x * gridDim.y * gridDim.z;
    unsigned sum, cnt, mine, sp = 0u;
    for (;;) {
        sum = 0u; cnt = 0u; mine = 0u;
#pragma unroll
        for (unsigned j = 0; j < 16; ++j) { const unsigned c = xb_ld(&bar[XB_XCNT(j)]); sum += c; cnt += (c > 0u) ? 1u : 0u; mine = (j == x) ? c : mine; }
        if (sum == G) break;
        __builtin_amdgcn_s_sleep(1);
        if ((++sp & 255u) == 0u) { if (xb_ld(&bar[XB_TMO])) break; if (sp > XB_SPIN_CAP) { atomicAdd(&bar[XB_TMO], 1u); break; } }
    }
    nloc = mine > 0u ? mine : 1u; nx = cnt > 0u ? cnt : 1u;
}

__device__ __forceinline__ void xcd_barrier(const XcdBarrier& b) {
    asm volatile("s_waitcnt vmcnt(0)" ::: "memory");
    __syncthreads();
    if (threadIdx.x == 0) {
        unsigned* bar = b.bar;
        __builtin_amdgcn_s_waitcnt(0);
        unsigned nloc = b.st[0], nx = b.st[1];
        if (nloc == 0u) { xcd_barrier_complete(bar, b.x, nloc, nx); b.st[0] = nloc; b.st[1] = nx; }
        const unsigned old = xb_add(&bar[XB_XSUB(b.x)], 1u);
        const unsigned gen = old / nloc;
        if (old + 1u == (gen + 1u) * nloc) {
            __builtin_amdgcn_fence(__ATOMIC_RELEASE, "agent");
            asm volatile("s_waitcnt vmcnt(0)" ::: "memory");
            const unsigned og = xb_add(&bar[XB_TOP], 1u);
            const unsigned tg = og / nx;
            if (og + 1u == (tg + 1u) * nx) xb_add(&bar[XB_TOPGEN], 1u);
            else XB_SPIN(xb_ld(&bar[XB_TOPGEN]) == tg, bar);
            __builtin_amdgcn_fence(__ATOMIC_ACQUIRE, "agent");
            xb_add(&bar[XB_XGEN(b.x)], 1u);
            asm volatile("s_waitcnt vmcnt(0)" ::: "memory");
        } else {
            XB_SPIN(xb_ld(&bar[XB_XGEN(b.x)]) == gen, bar);
            __builtin_amdgcn_fence(__ATOMIC_ACQUIRE, "agent");
            asm volatile("s_waitcnt vmcnt(0)" ::: "memory");
        }
    }
    __syncthreads();
}

constexpr int NWAVES = 8;
constexpr int BATCH = 2, SEQ = 16384, DM = 2048, T = BATCH * SEQ;
constexpr int GH = 4, GDK = 128, GDV = 256, GWK = 512, GWV = 1024, GRANK = 16;
constexpr int MH = 8, MDH = 128, MW = 1024, MBLK = 256, NBLK = SEQ / MBLK;
constexpr int NSRC = 11280;
constexpr int NPA = 5120, NPB = 6144;
constexpr int NP = 11520;
constexpr float NORM_EPS = 1e-6f;
constexpr int A_GQ = 0, A_GK = 512, A_GV = 1024, A_MQ = 2048, A_MK = 3072, A_MV = 4096;
constexpr int B_GS = 0, B_MS = 1024, B_GA = 2048, B_GB = 4096;

constexpr size_t MiB = 1u << 20;
constexpr size_t WS_CTL = 0, CTL_ZERO_BYTES = 1 * MiB;
constexpr size_t WS_KMEAN = 1 * MiB;
constexpr size_t WS_WIN = 2 * MiB;
constexpr size_t WS_WCAT = 47 * MiB;
constexpr size_t WS_WOUT = 55 * MiB;
constexpr size_t WS_GLR = 63 * MiB;
constexpr size_t WS_SEL = 65 * MiB;
constexpr size_t WS_XN = 70 * MiB;
constexpr size_t WS_ACAT = WS_XN;
constexpr size_t WS_PA = 198 * MiB;
constexpr size_t WS_MG = WS_PA;
constexpr size_t WS_PB = 518 * MiB;
constexpr size_t WS_END = 902 * MiB;

constexpr int CW_BAR = 4096;

constexpr int RING_OFF = 0, RING_BYTES = 131072;
constexpr int LDSCTL_OFF = RING_BYTES, MISC_OFF = LDSCTL_OFF + 320;
constexpr int LDS_BYTES = 147456;

__device__ __forceinline__ float bflo(unsigned u) { return __builtin_bit_cast(float, u << 16); }
__device__ __forceinline__ float bfhi(unsigned u) { return __builtin_bit_cast(float, u & 0xffff0000u); }
__device__ __forceinline__ float bf2f(unsigned short u) { return __builtin_bit_cast(float, (unsigned)u << 16); }
__device__ __forceinline__ float sigmoidf_(float v) { return __builtin_amdgcn_rcpf(1.0f + __builtin_amdgcn_exp2f(-1.44269504089f * v)); }
__device__ __forceinline__ float wave_sum(float v) {
#pragma unroll
    for (int o = 1; o < 64; o <<= 1) v += __shfl_xor(v, o);
    return v;
}
__device__ __forceinline__ float wave_max(float v) {
#pragma unroll
    for (int o = 1; o < 64; o <<= 1) v = fmaxf(v, __shfl_xor(v, o));
    return v;
}

namespace pg8 {
struct EpiProj {
    static constexpr bool PERM = true, AFTER_DRAIN = false, MID_HOOK = false;
    bf16_t* PA; bf16_t* PB; float* GLR;
    __device__ __forceinline__ void operator()(const f32x4 (&acc)[2][2][4][2], const Unit& u, int wr, int wc, int fr, int fq) const {
        const int pn = u.pn, row0 = u.pm * BM + wr * 64 + fr;
        if (pn < 20) {
            const float sc = pn < 2 ? 0.08838834764831845f : 1.0f;
            const int col0 = pn * BM + wc * 32 + 8 * fq;
#pragma unroll
            for (int ai = 0; ai < 2; ++ai)
#pragma unroll
                for (int m = 0; m < 4; ++m) { bf16_t* rowp = PA + (size_t)(row0 + ai * HALF + m * 16) * NPA + col0;
#pragma unroll
                    for (int bj = 0; bj < 2; ++bj) { const f32x4 v0 = acc[ai][bj][m][0] * sc, v1 = acc[ai][bj][m][1] * sc;
                        u32x4 w; w.x = cvt_pk_bf16(v0[0], v0[1]); w.y = cvt_pk_bf16(v0[2], v0[3]); w.z = cvt_pk_bf16(v1[0], v1[1]); w.w = cvt_pk_bf16(v1[2], v1[3]);
                        *(u32x4*)(rowp + bj * HALF) = w; } }
        } else if (pn < 44) {
            const bool is_silu = pn < 28;
            const int col0 = (pn - 20) * BM + wc * 32 + 8 * fq;
#pragma unroll
            for (int ai = 0; ai < 2; ++ai)
#pragma unroll
                for (int m = 0; m < 4; ++m) { bf16_t* rowp = PB + (size_t)(row0 + ai * HALF + m * 16) * NPB + col0;
#pragma unroll
                    for (int bj = 0; bj < 2; ++bj) { float v[8];
#pragma unroll
                        for (int i = 0; i < 4; ++i) { v[i] = acc[ai][bj][m][0][i]; v[4 + i] = acc[ai][bj][m][1][i]; }
#pragma unroll
                        for (int i = 0; i < 8; ++i) { const float s = sigmoidf_(v[i]); v[i] = is_silu ? v[i] * s : s; }
                        u32x4 w; w.x = cvt_pk_bf16(v[0], v[1]); w.y = cvt_pk_bf16(v[2], v[3]); w.z = cvt_pk_bf16(v[4], v[5]); w.w = cvt_pk_bf16(v[6], v[7]);
                        *(u32x4*)(rowp + bj * HALF) = w; } }
        } else {
            if (wc == 0 && fq < 2) {
#pragma unroll
                for (int ai = 0; ai < 2; ++ai)
#pragma unroll
                    for (int m = 0; m < 4; ++m) { float* rowp = GLR + (size_t)(row0 + ai * HALF + m * 16) * 16 + 8 * fq;
                        *(f32x4*)(rowp) = acc[ai][0][m][0]; *(f32x4*)(rowp + 4) = acc[ai][0][m][1]; }
            }
        }
    }
};
struct EpiMerge {
    static constexpr bool PERM = true, AFTER_DRAIN = false, MID_HOOK = true;
    const bf16_t* PB; bf16_t* MG;
    __device__ __forceinline__ void mid(f32x4 (&acc)[2][2][4][2], const Unit& u, int wr, int wc, int fr, int fq) const {
        int opq; asm volatile("v_mov_b32 %0, 0" : "=v"(opq));
        const int row0 = u.pm * BM + wr * 64 + fr + opq, col0 = u.pn * BM + wc * 32 + 8 * fq;
#pragma unroll
        for (int ai = 0; ai < 2; ++ai)
#pragma unroll
            for (int m = 0; m < 4; ++m) { const bf16_t* rowp = PB + (size_t)(row0 + ai * HALF + m * 16) * NPB + col0;
#pragma unroll
                for (int bj = 0; bj < 2; ++bj) {
                    const u32x4 a = *(const u32x4*)(rowp + B_GA + bj * HALF), b = *(const u32x4*)(rowp + B_GB + bj * HALF);
                    f32x4 r0, r1;
                    r0[0] = bflo(a.x) * __builtin_amdgcn_rcpf(bflo(b.x)); r0[1] = bfhi(a.x) * __builtin_amdgcn_rcpf(bfhi(b.x));
                    r0[2] = bflo(a.y) * __builtin_amdgcn_rcpf(bflo(b.y)); r0[3] = bfhi(a.y) * __builtin_amdgcn_rcpf(bfhi(b.y));
                    r1[0] = bflo(a.z) * __builtin_amdgcn_rcpf(bflo(b.z)); r1[1] = bfhi(a.z) * __builtin_amdgcn_rcpf(bfhi(b.z));
                    r1[2] = bflo(a.w) * __builtin_amdgcn_rcpf(bflo(b.w)); r1[3] = bfhi(a.w) * __builtin_amdgcn_rcpf(bfhi(b.w));
                    acc[ai][bj][m][0] = acc[ai][bj][m][0] * r0; acc[ai][bj][m][1] = acc[ai][bj][m][1] * r1; }
                __builtin_amdgcn_sched_barrier(0); }
    }
    __device__ __forceinline__ void operator()(const f32x4 (&acc)[2][2][4][2], const Unit& u, int wr, int wc, int fr, int fq) const {
        const int row0 = u.pm * BM + wr * 64 + fr, col0 = u.pn * BM + wc * 32 + 8 * fq;
#pragma unroll
        for (int ai = 0; ai < 2; ++ai)
#pragma unroll
            for (int m = 0; m < 4; ++m) { const size_t row = (size_t)(row0 + ai * HALF + m * 16); const bf16_t* gp = PB + row * NPB + B_GB + col0; bf16_t* op = MG + row * DM + col0;
#pragma unroll
                for (int bj = 0; bj < 2; ++bj) { const u32x4 b = *(const u32x4*)(gp + bj * HALF);
                    const f32x4 v0 = acc[ai][bj][m][0], v1 = acc[ai][bj][m][1];
                    u32x4 w; w.x = cvt_pk_bf16(v0[0] * bflo(b.x), v0[1] * bfhi(b.x)); w.y = cvt_pk_bf16(v0[2] * bflo(b.y), v0[3] * bfhi(b.y));
                    w.z = cvt_pk_bf16(v1[0] * bflo(b.z), v1[1] * bfhi(b.z)); w.w = cvt_pk_bf16(v1[2] * bflo(b.w), v1[3] * bfhi(b.w));
                    *(u32x4*)(op + bj * HALF) = w; } }
    }
};
struct EpiOut {
    static constexpr bool PERM = true, AFTER_DRAIN = false, MID_HOOK = false;
    const float* X; float* O;
    __device__ __forceinline__ void operator()(const f32x4 (&acc)[2][2][4][2], const Unit& u, int wr, int wc, int fr, int fq) const {
        const int row0 = u.pm * BM + wr * 64 + fr, col0 = u.pn * BM + wc * 32 + 8 * fq;
#pragma unroll
        for (int ai = 0; ai < 2; ++ai)
#pragma unroll
            for (int m = 0; m < 4; ++m) { const size_t off = (size_t)(row0 + ai * HALF + m * 16) * DM + col0;
#pragma unroll
                for (int bj = 0; bj < 2; ++bj) { const float* xp = X + off + bj * HALF; float* op = O + off + bj * HALF;
                    const f32x4 x0 = *(const f32x4*)xp, x1 = *(const f32x4*)(xp + 4);
                    *(f32x4*)op = x0 + acc[ai][bj][m][0]; *(f32x4*)(op + 4) = x1 + acc[ai][bj][m][1]; } }
    }
};
}

struct Frame {
    LAS unsigned char* lds;
    int tid, lane, wave, vcu, G;
    const float *x, *norm_g, *w_in, *w_gate, *b_gate, *gla_g, *qn_g, *kn_g, *w_bg, *w_bm, *w_out;
    float* out;
    bf16 *WIN, *WCAT, *WOUT, *XN, *ACAT, *PA, *PB, *MG;
    float *GLR, *KMEAN, *OG;
    int* SEL;
};

__device__ __forceinline__ int win_src_col(int d) {
    if (d < 2048) return d;
    if (d < 5120) return d - 2048 + 3088;
    if (d < 6144) return d - 5120 + 2064;
    if (d < 7168) return d - 6144 + 6160;
    if (d < 11264) return d - 7168 + 7184;
    if (d < 11280) return d - 11264 + 2048;
    return -1;
}
template <bool MAPPED>
__device__ __forceinline__ void transpose_item(const float* W, int Nsrc, bf16* WT, int ldk, int koff, int k0, int n0, LAS float* scr, int lane) {
    const int nn = n0 + (lane & 31);
    const int sc = MAPPED ? win_src_col(nn) : nn;
#pragma unroll 8
    for (int i = 0; i < 32; ++i) { const int kk = 2 * i + (lane >> 5); scr[kk * 33 + (lane & 31)] = sc >= 0 ? W[(size_t)(k0 + kk) * Nsrc + sc] : 0.f; }
    LDS_WAIT(); asm volatile("" ::: "memory");
    const int c = lane & 7;
#pragma unroll
    for (int j = 0; j < 4; ++j) { const int n = (lane >> 3) + 8 * j; const LAS float* s = scr + (8 * c) * 33 + n;
        v4u o; o.x = pk2(s[0 * 33], s[1 * 33]); o.y = pk2(s[2 * 33], s[3 * 33]); o.z = pk2(s[4 * 33], s[5 * 33]); o.w = pk2(s[6 * 33], s[7 * 33]);
        *(GAS v4u*)(WT + (size_t)(n0 + n) * ldk + koff + k0 + 8 * c) = o; }
    LDS_WAIT(); asm volatile("" ::: "memory");
}
__device__ __forceinline__ void p0_prologue(Frame& F) {
    LAS float* scr = (LAS float*)(F.lds + RING_OFF + F.wave * 16384);
    const int gw = F.vcu * NWAVES + F.wave, NGW = F.G * NWAVES;
    constexpr int NB_IN = 11296 / 32, I_IN = (DM / 64) * NB_IN;
    constexpr int I_BG = (1024 / 64) * (DM / 32), I_OUT = (DM / 64) * (DM / 32);
    constexpr int NITEMS = I_IN + 2 * I_BG + I_OUT;
    for (int it = gw; it < NITEMS; it += NGW) {
        int r = it;
        if (r < I_IN) { const int kb = r / NB_IN, nb = r % NB_IN; transpose_item<true>(F.w_in, NSRC, F.WIN, DM, 0, 64 * kb, 32 * nb, scr, F.lane); continue; } r -= I_IN;
        if (r < I_BG) { const int kb = r / (DM / 32), nb = r % (DM / 32); transpose_item<false>(F.w_bg, DM, F.WCAT, 2048, 0, 64 * kb, 32 * nb, scr, F.lane); continue; } r -= I_BG;
        if (r < I_BG) { const int kb = r / (DM / 32), nb = r % (DM / 32); transpose_item<false>(F.w_bm, DM, F.WCAT, 2048, 1024, 64 * kb, 32 * nb, scr, F.lane); continue; } r -= I_BG;
        { const int kb = r / (DM / 32), nb = r % (DM / 32); transpose_item<false>(F.w_out, DM, F.WOUT, DM, 0, 64 * kb, 32 * nb, scr, F.lane); }
    }
    f32x4 g[8];
#pragma unroll
    for (int j = 0; j < 8; ++j) g[j] = ((const GAS f32x4*)F.norm_g)[64 * j + F.lane];
    for (int m = gw; m < T; m += NGW) {
        const GAS f32x4* xr = (const GAS f32x4*)(F.x + (size_t)m * DM) + F.lane;
        f32x4 v[8]; float s = 0.f;
#pragma unroll
        for (int j = 0; j < 8; ++j) { v[j] = xr[64 * j]; s += (v[j].x * v[j].x + v[j].y * v[j].y) + (v[j].z * v[j].z + v[j].w * v[j].w); }
        const float r = 1.0f / sqrtf(wave_sum(s) * (1.0f / DM) + NORM_EPS);
        GAS unsigned long long* o8 = (GAS unsigned long long*)(F.XN + (size_t)m * DM) + F.lane;
#pragma unroll
        for (int j = 0; j < 8; ++j) { const f32x4 y = v[j] * r * g[j]; o8[64 * j] = (unsigned long long)pk2(y.x, y.y) | ((unsigned long long)pk2(y.z, y.w) << 32); }
    }
}

__device__ __forceinline__ void m0_qknorm(Frame& F) {
    LAS float* red = (LAS float*)(F.lds);
    const int rg = F.tid >> 4, l16 = F.tid & 15;
    for (int item = F.vcu; item < BATCH * NBLK * MH; item += F.G) {
        const int h = item % MH, blk = (item / MH) % NBLK, b = item / (MH * NBLK);
        float gq[8], gk[8], cs[8];
#pragma unroll
        for (int e = 0; e < 8; ++e) { gq[e] = F.qn_g[l16 * 8 + e]; gk[e] = F.kn_g[l16 * 8 + e]; cs[e] = 0.f; }
        for (int it = 0; it < 8; ++it) {
            const size_t row = (size_t)b * SEQ + blk * MBLK + it * 32 + rg;
#pragma unroll
            for (int w = 0; w < 2; ++w) {
                bf16* p = F.PA + row * NPA + (w ? A_MK : A_MQ) + h * MDH + l16 * 8;
                const v4u raw = *(const GAS v4u*)p; float v[8];
                v[0] = bflo(raw.x); v[1] = bfhi(raw.x); v[2] = bflo(raw.y); v[3] = bfhi(raw.y); v[4] = bflo(raw.z); v[5] = bfhi(raw.z); v[6] = bflo(raw.w); v[7] = bfhi(raw.w);
                float ss = 0.f;
#pragma unroll
                for (int e = 0; e < 8; ++e) ss += v[e] * v[e];
                ss += __shfl_xor(ss, 1); ss += __shfl_xor(ss, 2); ss += __shfl_xor(ss, 4); ss += __shfl_xor(ss, 8);
                const float r = 1.0f / sqrtf(ss * (1.0f / MDH) + NORM_EPS);
#pragma unroll
                for (int e = 0; e < 8; ++e) { v[e] = v[e] * r * (w ? gk[e] : gq[e]); if (w) cs[e] += v[e]; }
                v4u o; o.x = pk2(v[0], v[1]); o.y = pk2(v[2], v[3]); o.z = pk2(v[4], v[5]); o.w = pk2(v[6], v[7]);
                *(GAS v4u*)p = o;
            }
        }
#pragma unroll
        for (int e = 0; e < 8; ++e) red[rg * 128 + l16 * 8 + e] = cs[e];
        __syncthreads();
        if (F.tid < 128) { float s = 0.f;
#pragma unroll 8
            for (int r = 0; r < 32; ++r) s += red[r * 128 + F.tid];
            F.KMEAN[((size_t)(b * MH + h) * NBLK + blk) * MDH + F.tid] = s * (1.0f / MBLK); }
        __syncthreads();
    }
}

__device__ __forceinline__ void m1_select(Frame& F) {
    LAS float* km = (LAS float*)(F.lds);
    for (int item = F.vcu; item < BATCH * MH * (SEQ / 512); item += F.G) {
        const int qc = item % (SEQ / 512), h = (item / (SEQ / 512)) % MH, b = item / ((SEQ / 512) * MH);
        __syncthreads();
        for (int i = F.tid; i < NBLK * MDH; i += NWAVES * 64) { const int j = i / MDH, d = i % MDH; km[d * NBLK + j] = F.KMEAN[(size_t)(b * MH + h) * NBLK * MDH + i]; }
        __syncthreads();
        const int t = qc * 512 + F.tid, qb = t / MBLK;
        const bf16* qp = F.PA + ((size_t)b * SEQ + t) * NPA + A_MQ + h * MDH;
        float acc[NBLK];
#pragma unroll
        for (int j = 0; j < NBLK; ++j) acc[j] = 0.f;
        for (int c = 0; c < 16; ++c) {
            const v4u raw = *(const GAS v4u*)(qp + c * 8); float q[8];
            q[0] = bflo(raw.x); q[1] = bfhi(raw.x); q[2] = bflo(raw.y); q[3] = bfhi(raw.y); q[4] = bflo(raw.z); q[5] = bfhi(raw.z); q[6] = bflo(raw.w); q[7] = bfhi(raw.w);
#pragma unroll
            for (int e = 0; e < 8; ++e) { const LAS f32x4* kr = (const LAS f32x4*)(km + (c * 8 + e) * NBLK);
#pragma unroll
                for (int j4 = 0; j4 < NBLK / 4; ++j4) { const f32x4 kv = kr[j4];
                    acc[4 * j4 + 0] = fmaf(q[e], kv.x, acc[4 * j4 + 0]); acc[4 * j4 + 1] = fmaf(q[e], kv.y, acc[4 * j4 + 1]);
                    acc[4 * j4 + 2] = fmaf(q[e], kv.z, acc[4 * j4 + 2]); acc[4 * j4 + 3] = fmaf(q[e], kv.w, acc[4 * j4 + 3]); } }
        }
        unsigned long long taken = 0ull; int sel[4] = {-1, -1, -1, -1};
#pragma unroll
        for (int r = 0; r < 3; ++r) {
            float best = -3.0e38f; int bi = -1;
#pragma unroll
            for (int j = 0; j < NBLK; ++j) { const bool ok = (j < qb) && !((taken >> j) & 1ull) && (acc[j] > best); best = ok ? acc[j] : best; bi = ok ? j : bi; }
            sel[r] = bi; if (bi >= 0) taken |= (1ull << bi);
        }
        int4 o; o.x = sel[0]; o.y = sel[1]; o.z = sel[2]; o.w = -1;
        *(int4*)(F.SEL + (((size_t)(b * MH + h) * SEQ + t) * 4)) = o;
    }
}

__device__ __forceinline__ void m2_attn_naive(Frame& F) {
    LAS float* P = (LAS float*)(F.lds) + F.wave * 1024;
    const int gw = F.vcu * NWAVES + F.wave, NGW = F.G * NWAVES;
    for (int item = gw; item < BATCH * MH * SEQ; item += NGW) {
        const int t = item % SEQ, h = (item / SEQ) % MH, b = item / (SEQ * MH);
        const int own = t / MBLK;
        const int4 s4 = *(const int4*)(F.SEL + (((size_t)(b * MH + h) * SEQ + t) * 4));
        unsigned blks = 0u; int nb = 0;
        if (s4.x >= 0) { blks |= (unsigned)s4.x << (8 * nb); ++nb; } if (s4.y >= 0) { blks |= (unsigned)s4.y << (8 * nb); ++nb; } if (s4.z >= 0) { blks |= (unsigned)s4.z << (8 * nb); ++nb; }
        blks |= (unsigned)own << (8 * nb); ++nb;
        const float slope = __builtin_amdgcn_exp2f(-(float)(h + 1));
        const bf16* qp = F.PA + ((size_t)b * SEQ + t) * NPA + A_MQ + h * MDH;
        v4u q[16];
#pragma unroll
        for (int c = 0; c < 16; ++c) q[c] = *(const GAS v4u*)(qp + c * 8);
        float mx = -3.0e38f;
        for (int bi = 0; bi < nb; ++bi) {
            const int blk = (int)((blks >> (8 * bi)) & 0xffu);
            for (int kc = 0; kc < 4; ++kc) {
                const int pos = blk * MBLK + kc * 64 + F.lane;
                const bf16* kp = F.PA + ((size_t)b * SEQ + pos) * NPA + A_MK + h * MDH;
                float s = 0.f;
#pragma unroll
                for (int c = 0; c < 16; ++c) { const v4u kv = *(const GAS v4u*)(kp + c * 8);
                    s += bflo(kv.x) * bflo(q[c].x) + bfhi(kv.x) * bfhi(q[c].x) + bflo(kv.y) * bflo(q[c].y) + bfhi(kv.y) * bfhi(q[c].y)
                       + bflo(kv.z) * bflo(q[c].z) + bfhi(kv.z) * bfhi(q[c].z) + bflo(kv.w) * bflo(q[c].w) + bfhi(kv.w) * bfhi(q[c].w); }
                s = s * 0.08838834764831845f - slope * (float)(t - pos);
                if (pos > t) s = -1.0e30f;
                P[bi * 256 + kc * 64 + F.lane] = s; mx = fmaxf(mx, s);
            }
        }
        mx = wave_max(mx);
        float l = 0.f;
        for (int i = F.lane; i < nb * 256; i += 64) { const float p = __builtin_amdgcn_exp2f((P[i] - mx) * 1.44269504089f); P[i] = p; l += p; }
        l = wave_sum(l);
        LDS_WAIT(); asm volatile("" ::: "memory");
        float o0 = 0.f, o1 = 0.f;
        for (int bi = 0; bi < nb; ++bi) {
            const bf16* vp = F.PA + ((size_t)b * SEQ + (int)((blks >> (8 * bi)) & 0xffu) * MBLK) * NPA + A_MV + h * MDH + 2 * F.lane;
#pragma unroll 8
            for (int k = 0; k < 256; ++k) { const float p = P[bi * 256 + k]; const unsigned vv = *(const GAS unsigned*)(vp + (size_t)k * NPA); o0 = fmaf(p, bflo(vv), o0); o1 = fmaf(p, bfhi(vv), o1); }
        }
        const float inv = 1.0f / l;
        const unsigned gs = *(const GAS unsigned*)(F.PB + ((size_t)b * SEQ + t) * NPB + B_MS + h * MDH + 2 * F.lane);
        *(GAS unsigned*)(F.ACAT + ((size_t)b * SEQ + t) * 2048 + 1024 + h * MDH + 2 * F.lane) = pk2(o0 * inv * bflo(gs), o1 * inv * bfhi(gs));
        LDS_WAIT(); asm volatile("" ::: "memory");
    }
}

__device__ __forceinline__ void gla_naive(Frame& F) {
    LAS float* Wg = (LAS float*)(F.lds);
    LAS float* bg = Wg + 16 * 128;
    LAS float* glr = bg + 128;
    LAS float* aa = glr + 64 * 16;
    LAS float* qq = aa + 64 * 128;
    LAS float* kk = qq + 64 * 128;
    LAS float* vv = kk + 64 * 128;
    for (int item = F.vcu; item < BATCH * GH * (GDV / 8); item += F.G) {
        const int dvs = item % (GDV / 8), h = (item / (GDV / 8)) % GH, b = item / ((GDV / 8) * GH);
        __syncthreads();
        for (int i = F.tid; i < 16 * 128; i += 512) Wg[i] = F.w_gate[(size_t)(i / 128) * GWK + h * GDK + (i % 128)];
        if (F.tid < 128) bg[F.tid] = F.b_gate[h * GDK + F.tid];
        float S0 = 0.f, S1 = 0.f;
        const int dv = dvs * 8 + F.wave;
        for (int c0 = 0; c0 < SEQ; c0 += 64) {
            __syncthreads();
            const size_t rowb = (size_t)b * SEQ + c0;
            for (int i = F.tid; i < 64 * 16; i += 512) glr[i] = F.GLR[rowb * 16 + i];
            for (int i = F.tid; i < 64 * 128; i += 512) { const int r = i >> 7, d = i & 127; const bf16* p = F.PA + (rowb + r) * NPA + h * GDK + d; qq[i] = bf2f(p[A_GQ]); kk[i] = bf2f(p[A_GK]); }
            { const int r = F.tid >> 3, j = F.tid & 7; vv[F.tid] = bf2f(F.PA[(rowb + r) * NPA + A_GV + h * GDV + dvs * 8 + j]); }
            __syncthreads();
            for (int i = F.tid; i < 64 * 128; i += 512) { const int r = i >> 7, d = i & 127; float z = bg[d];
#pragma unroll
                for (int j = 0; j < 16; ++j) z = fmaf(glr[r * 16 + j], Wg[j * 128 + d], z);
                const float ls = fminf(z, 0.f) - log1pf(expf(-fabsf(z)));
                aa[i] = expf(ls * (1.0f / 16.0f)); }
            __syncthreads();
            for (int r = 0; r < 64; ++r) {
                const float v = vv[r * 8 + F.wave];
                S0 = aa[r * 128 + F.lane] * S0 + kk[r * 128 + F.lane] * v;
                S1 = aa[r * 128 + 64 + F.lane] * S1 + kk[r * 128 + 64 + F.lane] * v;
                const float o = wave_sum(qq[r * 128 + F.lane] * S0 + qq[r * 128 + 64 + F.lane] * S1);
                if (F.lane == 0) F.OG[(rowb + r) * GWV + h * GDV + dv] = o;
            }
        }
    }
}
__device__ __forceinline__ void gla_post(Frame& F) {
    const int gw = F.vcu * NWAVES + F.wave, NGW = F.G * NWAVES;
    const f32x4 g = ((const GAS f32x4*)F.gla_g)[F.lane];
    for (int item = gw; item < T * GH; item += NGW) {
        const int h = item % GH; const size_t row = item / GH;
        const f32x4 o = ((const GAS f32x4*)(F.OG + row * GWV + h * GDV))[F.lane];
        const float ss = wave_sum((o.x * o.x + o.y * o.y) + (o.z * o.z + o.w * o.w));
        const float r = 1.0f / sqrtf(ss * (1.0f / GDV) + NORM_EPS);
        const unsigned long long gs = *(const GAS unsigned long long*)(F.PB + row * NPB + B_GS + h * GDV + 4 * F.lane);
        const unsigned lo = (unsigned)gs, hi = (unsigned)(gs >> 32);
        const unsigned long long w = (unsigned long long)pk2(o.x * r * g.x * bflo(lo), o.y * r * g.y * bfhi(lo)) | ((unsigned long long)pk2(o.z * r * g.z * bflo(hi), o.w * r * g.w * bfhi(hi)) << 32);
        *(GAS unsigned long long*)(F.ACAT + row * 2048 + h * GDV + 4 * F.lane) = w;
    }
}

constexpr int N_PHASES = 9;
#ifndef MK_N_LAUNCHES
#define MK_N_LAUNCHES 1
#endif
struct Args { const float* in[11]; float* out; unsigned char* ws; int ph_lo, ph_hi; };
__global__ void __launch_bounds__(NWAVES * 64, 2) mk_fwd(Args args) {
    extern __shared__ __attribute__((aligned(16))) unsigned char lds[];
    Frame F;
    F.lds = (LAS unsigned char*)lds;
    F.tid = threadIdx.x; F.lane = F.tid & 63; F.wave = __builtin_amdgcn_readfirstlane(F.tid >> 6);
    F.G = gridDim.x; { const int bx = blockIdx.x; F.vcu = (F.G % 8 == 0) ? (bx % 8) * (F.G / 8) + bx / 8 : bx; }
    unsigned char* ws = args.ws;
    F.x = args.in[0]; F.norm_g = args.in[1]; F.w_in = args.in[2]; F.w_gate = args.in[3]; F.b_gate = args.in[4]; F.gla_g = args.in[5];
    F.qn_g = args.in[6]; F.kn_g = args.in[7]; F.w_bg = args.in[8]; F.w_bm = args.in[9]; F.w_out = args.in[10]; F.out = args.out;
    F.WIN = (bf16*)(ws + WS_WIN); F.WCAT = (bf16*)(ws + WS_WCAT); F.WOUT = (bf16*)(ws + WS_WOUT); F.XN = (bf16*)(ws + WS_XN); F.ACAT = (bf16*)(ws + WS_ACAT);
    F.PA = (bf16*)(ws + WS_PA); F.PB = (bf16*)(ws + WS_PB); F.MG = (bf16*)(ws + WS_MG);
    F.GLR = (float*)(ws + WS_GLR); F.KMEAN = (float*)(ws + WS_KMEAN); F.OG = args.out; F.SEL = (int*)(ws + WS_SEL);
    volatile LAS unsigned* MISC = (volatile LAS unsigned*)(F.lds + MISC_OFF);
    for (int u = F.tid; u < (LDS_BYTES - LDSCTL_OFF) / 4; u += NWAVES * 64) ((LAS unsigned*)(F.lds + LDSCTL_OFF))[u] = 0u;
    __syncthreads();
    const int lo = args.ph_lo, hi = args.ph_hi;
    XcdBarrier bar; bar.bar = (unsigned*)(ws + WS_CTL) + CW_BAR; bar.x = 0; bar.st = nullptr;
    if (hi - lo > 1) bar = xcd_barrier_post((unsigned*)(ws + WS_CTL) + CW_BAR, MISC + 8);
#ifndef PH_MASK
#define PH_MASK 0x1ff
#endif
#define IN(k) (((PH_MASK >> (k)) & 1) && lo <= (k) && (k) < hi)
#define SEAM(k) do { if (IN(k) && IN((k) + 1)) xcd_barrier(bar); } while (0)

    if (IN(0)) { p0_prologue(F); } SEAM(0);
    if (IN(1)) {
        pg8::Gemm g{F.XN, F.WIN, T, NP, DM}; pg8::StaticOrder S; S.init(T, NP, F.G, (int)blockIdx.x);
        pg8::EpiProj E{F.PA, F.PB, F.GLR};
        pg8::gemm_phase<pg8::EpiProj, pg8::StaticOrder, true, true>(F.lds + RING_OFF, g, S, E);
    } SEAM(1);
    if (IN(2)) { m0_qknorm(F); } SEAM(2);
    if (IN(3)) { m1_select(F); } SEAM(3);
    if (IN(4)) { m2_attn_naive(F); } SEAM(4);
    if (IN(5)) { gla_naive(F); } SEAM(5);
    if (IN(6)) { gla_post(F); } SEAM(6);
    if (IN(7)) {
        pg8::Gemm g{F.ACAT, F.WCAT, T, DM, 2048}; pg8::StaticOrder S; S.init(T, DM, F.G, (int)blockIdx.x);
        pg8::EpiMerge E{F.PB, F.MG};
        pg8::gemm_phase<pg8::EpiMerge, pg8::StaticOrder, true, true>(F.lds + RING_OFF, g, S, E);
    } SEAM(7);
    if (IN(8)) {
        pg8::Gemm g{F.MG, F.WOUT, T, DM, DM}; pg8::StaticOrder S; S.init(T, DM, F.G, (int)blockIdx.x);
        pg8::EpiOut E{F.x, F.out};
        pg8::gemm_phase<pg8::EpiOut, pg8::StaticOrder, true, true>(F.lds + RING_OFF, g, S, E);
    }
#undef IN
#undef SEAM
}

extern "C" void kernel_launch(void* const* d_in, const int* in_sizes, int n_in, void* d_out, int out_size, void* d_ws, size_t ws_size, hipStream_t stream) {
    static int grid = 0;
    if (grid == 0) {
        if (n_in != 11 || in_sizes[0] != T * DM || out_size != T * DM || ws_size < WS_END) { fprintf(stderr, "kernel_launch: unexpected shapes (n_in %d, in0 %d, out %d, ws %zu)\n", n_in, n_in > 0 ? in_sizes[0] : -1, out_size, ws_size); grid = -1; return; }
        int dev = 0, cus = 0, per_cu = 0;
        if (hipGetDevice(&dev) != hipSuccess || hipDeviceGetAttribute(&cus, hipDeviceAttributeMultiprocessorCount, dev) != hipSuccess) { grid = -1; return; }
        if (hipFuncSetAttribute((const void*)mk_fwd, hipFuncAttributeMaxDynamicSharedMemorySize, LDS_BYTES) != hipSuccess) { fprintf(stderr, "kernel_launch: hipFuncSetAttribute failed\n"); grid = -1; return; }
        if (hipOccupancyMaxActiveBlocksPerMultiprocessor(&per_cu, (const void*)mk_fwd, NWAVES * 64, LDS_BYTES) != hipSuccess || per_cu < 1) { fprintf(stderr, "kernel_launch: occupancy query says %d blocks per CU\n", per_cu); per_cu = 1; }
        (void)hipGetLastError();
        grid = cus;
    }
    if (grid < 0) return;
    (void)hipMemsetAsync((char*)d_ws + WS_CTL, 0, CTL_ZERO_BYTES, stream);
    Args a{};
    for (int i = 0; i < 11; ++i) a.in[i] = (const float*)d_in[i];
    a.out = (float*)d_out; a.ws = (unsigned char*)d_ws;
    constexpr int NL = MK_N_LAUNCHES;
    for (int li = 0; li < NL; ++li) {
        a.ph_lo = (NL == 1) ? 0 : li; a.ph_hi = (NL == 1) ? N_PHASES : li + 1;
        void* kargs[] = {(void*)&a};
        hipError_t e = hipLaunchCooperativeKernel((const void*)mk_fwd, dim3(grid), dim3(NWAVES * 64), kargs, LDS_BYTES, stream);
        if (e != hipSuccess) { fprintf(stderr, "kernel_launch: cooperative launch failed: %s (grid %d)\n", hipGetErrorString(e), grid); (void)hipGetLastError(); }
    }
}
```

```cpp
#include <hip/hip_runtime.h>
#include <cstdio>
#include <cstdint>
namespace pg8 {
#define PG8_LAS __attribute__((address_space(3)))
typedef unsigned short bf16_t;
typedef short bf16x8 __attribute__((ext_vector_type(8)));
typedef float f32x4 __attribute__((ext_vector_type(4)));
typedef unsigned u32x4 __attribute__((ext_vector_type(4)));
constexpr int BM = 256, BK = 64, HALF = 128, HTB = HALF * BK * 2  , STAGE_BYTES = 8 * HTB, NXCD = 8, WGM = 8;

__host__ __device__ __forceinline__ int lds_byte(int r, int c) { const int st = (r >> 4) * 2 + (c >> 5), rr = r & 15, cc = c & 31, ob = rr * 64 + cc * 2; return st * 1024 + (ob ^ (((ob >> 9) & 1) << 5)); }
__host__ __device__ __forceinline__ void stage_rc(int b, int& R, int& C) { const int st = b / 1024, sb = b % 1024, swz = sb ^ (((sb >> 9) & 1) << 5); R = (st >> 1) * 16 + swz / 64; C = (st & 1) * 32 + (swz % 64) / 2; }
__host__ __device__ __forceinline__ int perm32(int rho) { const int n = rho >> 4, i = rho & 15; return 8 * (i >> 2) + 4 * n + (i & 3); }

struct Unit { int pm, pn; };
struct Gemm { const bf16_t* A; const bf16_t* Bt; int M, N, K; };

struct StaticOrder {
    int nM, nN, nwg, G, c;
    __host__ __device__ void init(int M, int N, int G_, int c_) { nM = M / BM; nN = N / BM; nwg = nM * nN; G = G_; c = c_; }
    __host__ __device__ bool next(int i, Unit& u) const {
        const long L = (long)i * G + c; if (L >= nwg) return false;
        int wgid = (int)L; { const int q = nwg / NXCD, r = nwg % NXCD, xcd = wgid % NXCD, off = wgid / NXCD; wgid = (xcd < r ? xcd * (q + 1) : r * (q + 1) + (xcd - r) * q) + off; }
        const int nig = WGM * nN, gid = wgid / nig, fm = gid * WGM, gsz = (nM - fm) < WGM ? (nM - fm) : WGM;
        u.pm = fm + ((wgid % nig) % gsz); u.pn = (wgid % nig) / gsz; return true;
    }
    __device__ __forceinline__ void a_ready(const Unit&) const {}
    __device__ __forceinline__ void done(const Unit&) const {}
};

__device__ __forceinline__ unsigned cvt_pk_bf16(float lo, float hi) { unsigned r; asm volatile("v_cvt_pk_bf16_f32 %0, %1, %2" : "=v"(r) : "v"(lo), "v"(hi)); return r; }

template <class Epi, class Sched, bool ALIGN_EPI = false, bool SP2 = false>
__device__ __forceinline__ void gemm_phase(PG8_LAS unsigned char* lds, const Gemm g, const Sched& S, const Epi& E) {
    const int tid = threadIdx.x, wid = __builtin_amdgcn_readfirstlane(tid >> 6), lane = tid & 63, wr = wid >> 2, wc = wid & 3, fr = lane & 15, fq = lane >> 4;
    const int K = g.K, nt = K / BK;
    unsigned voffA[2], voffB[2];
#pragma unroll
    for (int i = 0; i < 2; ++i) { int R, C; stage_rc(tid * 16 + i * 8192, R, C); const int Rb = Epi::PERM ? ((R & ~31) + perm32(R & 31)) : R;
        voffA[i] = (unsigned)(R * K + C) * 2u; voffB[i] = (unsigned)(Rb * K + C) * 2u; }
    const size_t kstep = (size_t)(BK * 2);
    const size_t hstep = (size_t)HALF * K * 2;
    const size_t tstep = 2 * hstep;
    const unsigned ldsw = (unsigned)wid * 1024u;
    const int aoff = lds_byte(wr * 64 + fr, fq * 8), boff = lds_byte(wc * 32 + fr, fq * 8);
#define PG8_SA(b, h) (((b) * 2 + (h)) * HTB)
#define PG8_SB(b, h) ((4 + (b) * 2 + (h)) * HTB)
#define PG8_STAGE(bufoff, gbase, voff) do { _Pragma("unroll") for (int _i = 0; _i < 2; ++_i) \
        __builtin_amdgcn_global_load_lds((const unsigned*)((const char*)(gbase) + (voff)[_i]), (PG8_LAS unsigned*)(lds + (bufoff) + ldsw + _i * 8192), 16, 0, 0); } while (0)
#define PG8_LDA(dst, b, h) do { _Pragma("unroll") for (int m = 0; m < 4; ++m) _Pragma("unroll") for (int k = 0; k < 2; ++k) dst[m][k] = *(const PG8_LAS bf16x8*)(lds + PG8_SA(b, h) + aoff + m * 2048 + k * 1024); } while (0)
#define PG8_LDB(dst, b, h) do { _Pragma("unroll") for (int n = 0; n < 2; ++n) _Pragma("unroll") for (int k = 0; k < 2; ++k) dst[n][k] = *(const PG8_LAS bf16x8*)(lds + PG8_SB(b, h) + boff + n * 2048 + k * 1024); } while (0)
#define PG8_MMA(ai, bj, At, Bt) do { __builtin_amdgcn_s_setprio(1); _Pragma("unroll") for (int m = 0; m < 4; ++m) _Pragma("unroll") for (int n = 0; n < 2; ++n) _Pragma("unroll") for (int k = 0; k < 2; ++k) \
        acc[ai][bj][m][n] = __builtin_amdgcn_mfma_f32_16x16x32_bf16(Bt[n][k], At[m][k], acc[ai][bj][m][n], 0, 0, 0); __builtin_amdgcn_s_setprio(0); } while (0)
#define PG8_WAIT_V(n) asm volatile("s_waitcnt vmcnt(" #n ")" ::: "memory")
#define PG8_WAIT_L(n) asm volatile("s_waitcnt lgkmcnt(" #n ")" ::: "memory")
#define PG8_BAR __builtin_amdgcn_s_barrier()
#define PG8_SCHED __builtin_amdgcn_sched_barrier(0)
    Unit cur, nxt; int ui = 0;
    if (!S.next(0, cur)) return;
    f32x4 acc[2][2][4][2];
#pragma unroll
    for (int a = 0; a < 2; ++a)
#pragma unroll
        for (int b = 0; b < 2; ++b)
#pragma unroll
            for (int m = 0; m < 4; ++m)
#pragma unroll
                for (int n = 0; n < 2; ++n) acc[a][b][m][n] = (f32x4){0.f, 0.f, 0.f, 0.f};
    bf16x8 At[4][2], B0[2][2], B1[2][2];
    const char* cA = (const char*)g.A + (size_t)cur.pm * tstep; const char* cB = (const char*)g.Bt + (size_t)cur.pn * tstep;
    S.a_ready(cur);
    if constexpr (SP2) {
        PG8_STAGE(PG8_SB(0, 0), cB, voffB); PG8_STAGE(PG8_SB(0, 1), cB + hstep, voffB); PG8_STAGE(PG8_SA(0, 0), cA, voffA); PG8_STAGE(PG8_SA(0, 1), cA + hstep, voffA);
        if (wr == 1) PG8_BAR;
        PG8_WAIT_V(2); PG8_BAR;
        PG8_STAGE(PG8_SB(1, 0), cB + kstep, voffB); PG8_STAGE(PG8_SA(1, 0), cA + kstep, voffA); PG8_STAGE(PG8_SB(1, 1), cB + hstep + kstep, voffB);
        PG8_WAIT_V(6); PG8_BAR;
    } else {
        PG8_STAGE(PG8_SB(0, 0), cB, voffB); PG8_STAGE(PG8_SA(0, 0), cA, voffA); PG8_STAGE(PG8_SB(0, 1), cB + hstep, voffB); PG8_STAGE(PG8_SA(0, 1), cA + hstep, voffA);
        if (wr == 1) PG8_BAR;
        PG8_WAIT_V(4); PG8_BAR;
        PG8_STAGE(PG8_SB(1, 0), cB + kstep, voffB); PG8_STAGE(PG8_SA(1, 0), cA + kstep, voffA); PG8_STAGE(PG8_SB(1, 1), cB + hstep + kstep, voffB);
        PG8_WAIT_V(6); PG8_BAR;
    }
    for (;;) {
        const bool has_next = S.next(ui + 1, nxt);
        const char* nA = has_next ? (const char*)g.A + (size_t)nxt.pm * tstep : cA; const char* nB = has_next ? (const char*)g.Bt + (size_t)nxt.pn * tstep : cB;
        for (int t = 0; t < nt; t += 2) {
            if constexpr (Epi::MID_HOOK) { if (t == nt / 2) E.mid(acc, cur, wr, wc, fr, fq); }
            const bool last = (t == nt - 2);
            const char* a1 = cA + (size_t)(t + 1) * kstep;
            const char* a2 = last ? nA : cA + (size_t)(t + 2) * kstep; const char* b2 = last ? nB : cB + (size_t)(t + 2) * kstep;
            const char* a3 = a2 + kstep; const char* b3 = b2 + kstep;
            if (last && has_next) S.a_ready(nxt);
            if constexpr (SP2) {
            PG8_LDB(B0, 0, 0); PG8_LDB(B1, 0, 1); PG8_SCHED; PG8_LDA(At, 0, 0); PG8_STAGE(PG8_SA(1, 1), a1 + hstep, voffA);
            PG8_WAIT_V(8); PG8_WAIT_L(0); PG8_BAR; PG8_MMA(0, 0, At, B0); PG8_MMA(0, 1, At, B1); PG8_BAR; PG8_SCHED;
            PG8_LDA(At, 0, 1); PG8_STAGE(PG8_SB(0, 0), b2, voffB); PG8_STAGE(PG8_SB(0, 1), b2 + hstep, voffB); PG8_STAGE(PG8_SA(0, 0), a2, voffA);
            PG8_WAIT_V(8); PG8_WAIT_L(0); PG8_BAR; PG8_MMA(1, 0, At, B0); PG8_MMA(1, 1, At, B1); PG8_BAR; PG8_SCHED;
            PG8_LDB(B0, 1, 0); PG8_LDB(B1, 1, 1); PG8_SCHED; PG8_LDA(At, 1, 0); PG8_STAGE(PG8_SA(0, 1), a2 + hstep, voffA);
            PG8_WAIT_V(8); PG8_WAIT_L(0); PG8_BAR; PG8_MMA(0, 0, At, B0); PG8_MMA(0, 1, At, B1); PG8_BAR; PG8_SCHED;
            PG8_LDA(At, 1, 1); PG8_STAGE(PG8_SB(1, 0), b3, voffB); PG8_STAGE(PG8_SB(1, 1), b3 + hstep, voffB); PG8_STAGE(PG8_SA(1, 0), a3, voffA);
            PG8_WAIT_V(8); PG8_WAIT_L(0); PG8_BAR; PG8_MMA(1, 0, At, B0); PG8_MMA(1, 1, At, B1); PG8_BAR; PG8_SCHED;
            } else {
            PG8_LDB(B0, 0, 0); PG8_SCHED; PG8_LDA(At, 0, 0); PG8_STAGE(PG8_SA(1, 1), a1 + hstep, voffA);
            PG8_WAIT_L(8); PG8_BAR; PG8_WAIT_L(0); PG8_MMA(0, 0, At, B0); PG8_BAR; PG8_SCHED;
            PG8_LDB(B1, 0, 1); PG8_STAGE(PG8_SB(0, 0), b2, voffB);
            PG8_BAR; PG8_WAIT_L(0); PG8_MMA(0, 1, At, B1); PG8_BAR;
            PG8_LDA(At, 0, 1); PG8_STAGE(PG8_SA(0, 0), a2, voffA);
            PG8_BAR; PG8_WAIT_L(0); PG8_MMA(1, 0, At, B0); PG8_BAR; PG8_SCHED;
            PG8_STAGE(PG8_SB(0, 1), b2 + hstep, voffB);
            PG8_WAIT_V(6); PG8_BAR; PG8_MMA(1, 1, At, B1); PG8_BAR;
            PG8_LDB(B0, 1, 0); PG8_SCHED; PG8_LDA(At, 1, 0); PG8_STAGE(PG8_SA(0, 1), a2 + hstep, voffA);
            PG8_WAIT_L(8); PG8_BAR; PG8_WAIT_L(0); PG8_MMA(0, 0, At, B0); PG8_BAR; PG8_SCHED;
            PG8_LDB(B1, 1, 1); PG8_STAGE(PG8_SB(1, 0), b3, voffB);
            PG8_BAR; PG8_WAIT_L(0); PG8_MMA(0, 1, At, B1); PG8_BAR;
            PG8_LDA(At, 1, 1); PG8_STAGE(PG8_SA(1, 0), a3, voffA);
            PG8_BAR; PG8_WAIT_L(0); PG8_MMA(1, 0, At, B0); PG8_BAR; PG8_SCHED;
            PG8_STAGE(PG8_SB(1, 1), b3 + hstep, voffB);
            PG8_WAIT_V(6); PG8_BAR; PG8_MMA(1, 1, At, B1); PG8_BAR;
            }
        }
        if constexpr (ALIGN_EPI) { if (wr == 0) PG8_BAR; }
        if constexpr (!Epi::AFTER_DRAIN) { E(acc, cur, wr, wc, fr, fq); S.done(cur); }
        if (!has_next) break;
#pragma unroll
        for (int a = 0; a < 2; ++a)
#pragma unroll
            for (int b = 0; b < 2; ++b)
#pragma unroll
                for (int m = 0; m < 4; ++m)
#pragma unroll
                    for (int n = 0; n < 2; ++n) acc[a][b][m][n] = (f32x4){0.f, 0.f, 0.f, 0.f};
        cur = nxt; cA = nA; cB = nB; ++ui;
        if constexpr (ALIGN_EPI) { if (wr == 1) PG8_BAR; }
    }
    PG8_WAIT_V(0);
    if constexpr (!ALIGN_EPI) { if (wr == 0) PG8_BAR; }
    PG8_BAR;
    if constexpr (Epi::AFTER_DRAIN) { E.fused(acc, cur, wr, wc, fr, fq, lds, wid, lane); S.done(cur); }
#undef PG8_SA
#undef PG8_SB
#undef PG8_STAGE
#undef PG8_LDA
#undef PG8_LDB
#undef PG8_MMA
#undef PG8_WAIT_V
#undef PG8_WAIT_L
#undef PG8_BAR
#undef PG8_SCHED
}
}
#define GAS __attribute__((address_space(1)))
#define LAS __attribute__((address_space(3)))
typedef unsigned short bf16;
typedef unsigned v4u __attribute__((ext_vector_type(4)));
typedef float f32x4 __attribute__((ext_vector_type(4)));
typedef short bf16x8 __attribute__((ext_vector_type(8)));
typedef GAS unsigned gu32;
typedef GAS unsigned long long gu64;
#define RLX_AGENT __ATOMIC_RELAXED, __HIP_MEMORY_SCOPE_AGENT
#define LDS_WAIT() asm volatile("s_waitcnt lgkmcnt(0)" ::: "memory")
#define VM_WAIT() asm volatile("s_waitcnt vmcnt(0)" ::: "memory")
__device__ __forceinline__ unsigned long long rt() { return __builtin_amdgcn_s_memrealtime(); }
__device__ __forceinline__ unsigned f2bf(float f) { unsigned u = __builtin_bit_cast(unsigned, f); return (u + 0x7fffu + ((u >> 16) & 1u)) >> 16; }
__device__ __forceinline__ unsigned pk2(float lo, float hi) { return f2bf(lo) | (f2bf(hi) << 16); }

#define XB_TMO      128
#define XB_XCNT(j)  (256  + 64 * (j))
#define XB_XSUB(j)  (1280 + 64 * (j))
#define XB_XGEN(j)  (2304 + 64 * (j))
#define XB_TOP      3328
#define XB_TOPGEN   3392
#define XCD_BAR_WORDS 3456
#define XB_SPIN_CAP (1u << 24)

__device__ __forceinline__ unsigned xb_ld(unsigned* p)              { return __hip_atomic_load(p, __ATOMIC_RELAXED, __HIP_MEMORY_SCOPE_AGENT); }
__device__ __forceinline__ unsigned xb_add(unsigned* p, unsigned v) { return __hip_atomic_fetch_add(p, v, __ATOMIC_RELAXED, __HIP_MEMORY_SCOPE_AGENT); }
__device__ __forceinline__ unsigned xb_xcc_id() { return (unsigned)__builtin_amdgcn_s_getreg((3 << 11) | 20) & 0xFu; }
#define XB_SPIN(cond, bar) do { unsigned _sp = 0; while (cond) { __builtin_amdgcn_s_sleep(1); \
    if ((++_sp & 255u) == 0u) { if (xb_ld(&(bar)[XB_TMO])) break; if (_sp > XB_SPIN_CAP) { atomicAdd(&(bar)[XB_TMO], 1u); break; } } } } while (0)

struct XcdBarrier {
    unsigned* bar; unsigned x;
    volatile LAS unsigned* st;
};

__device__ __forceinline__ XcdBarrier xcd_barrier_post(unsigned* bar, volatile LAS unsigned* st) {
    XcdBarrier b; b.bar = bar; b.x = xb_xcc_id(); b.st = st;
    if (threadIdx.x == 0) (void)xb_add(&bar[XB_XCNT(b.x)], 1u);
    return b;
}
__device__ __forceinline__ void xcd_barrier_complete(unsigned* bar, unsigned x, unsigned& nloc, unsigned& nx) {
    const unsigned G = gridDim.x * gridDim.y * gridDim.z;
    unsigned sum, cnt, mine, sp = 0u;
    for (;;) {
        sum = 0u; cnt = 0u; mine = 0u;
#pragma unroll
        for (unsigned j = 0; j < 16; ++j) { const unsigned c = xb_ld(&bar[XB_XCNT(j)]); sum += c; cnt += (c > 0u) ? 1u : 0u; mine = (j == x) ? c : mine; }
        if (sum == G) break;
        __builtin_amdgcn_s_sleep(1);
        if ((++sp & 255u) == 0u) { if (xb_ld(&bar[XB_TMO])) break; if (sp > XB_SPIN_CAP) { atomicAdd(&bar[XB_TMO], 1u); break; } }
    }
    nloc = mine > 0u ? mine : 1u; nx = cnt > 0u ? cnt : 1u;
}

__device__ __forceinline__ void xcd_barrier(const XcdBarrier& b) {
    asm volatile("s_waitcnt vmcnt(0)" ::: "memory");
    __syncthreads();
    if (threadIdx.x == 0) {
        unsigned* bar = b.bar;
        __builtin_amdgcn_s_waitcnt(0);
        unsigned nloc = b.st[0], nx = b.st[1];
        if (nloc == 0u) { xcd_barrier_complete(bar, b.x, nloc, nx); b.st[0] = nloc; b.st[1] = nx; }
        const unsigned old = xb_add(&bar[XB_XSUB(b.x)], 1u);
        const unsigned gen = old / nloc;
        if (old + 1u == (gen + 1u) * nloc) {
            __builtin_amdgcn_fence(__ATOMIC_RELEASE, "agent");
            asm volatile("s_waitcnt vmcnt(0)" ::: "memory");
            const unsigned og = xb_add(&bar[XB_TOP], 1u);
            const unsigned tg = og / nx;
            if (og + 1u == (tg + 1u) * nx) xb_add(&bar[XB_TOPGEN], 1u);
            else XB_SPIN(xb_ld(&bar[XB_TOPGEN]) == tg, bar);
            __builtin_amdgcn_fence(__ATOMIC_ACQUIRE, "agent");
            xb_add(&bar[XB_XGEN(b.x)], 1u);
            asm volatile("s_waitcnt vmcnt(0)" ::: "memory");
        } else {
            XB_SPIN(xb_ld(&bar[XB_XGEN(b.x)]) == gen, bar);
            __builtin_amdgcn_fence(__ATOMIC_ACQUIRE, "agent");
            asm volatile("s_waitcnt vmcnt(0)" ::: "memory");
        }
    }
    __syncthreads();
}

constexpr int NWAVES = 8;
constexpr int BATCH = 2, SEQ = 16384, DM = 2048, T = BATCH * SEQ;
constexpr int GH = 4, GDK = 128, GDV = 256, GWK = 512, GWV = 1024, GRANK = 16;
constexpr int MH = 8, MDH = 128, MW = 1024, MBLK = 256, NBLK = SEQ / MBLK;
constexpr int NSRC = 11280;
constexpr int NPA = 5120, NPB = 6144;
constexpr int NP = 11520;
constexpr float NORM_EPS = 1e-6f;
constexpr int A_GQ = 0, A_GK = 512, A_GV = 1024, A_MQ = 2048, A_MK = 3072, A_MV = 4096;
constexpr int B_GS = 0, B_MS = 1024, B_GA = 2048, B_GB = 4096;

constexpr size_t MiB = 1u << 20;
constexpr size_t WS_CTL = 0, CTL_ZERO_BYTES = 1 * MiB;
constexpr size_t WS_KMEAN = 1 * MiB;
constexpr size_t WS_WIN = 2 * MiB;
constexpr size_t WS_WCAT = 47 * MiB;
constexpr size_t WS_WOUT = 55 * MiB;
constexpr size_t WS_GLR = 63 * MiB;
constexpr size_t WS_SEL = 65 * MiB;
constexpr size_t WS_XN = 70 * MiB;
constexpr size_t WS_ACAT = WS_XN;
constexpr size_t WS_PA = 198 * MiB;
constexpr size_t WS_MG = WS_PA;
constexpr size_t WS_PB = 518 * MiB;
constexpr size_t WS_DEC = 902 * MiB;
constexpr size_t WS_DG = 904 * MiB;
constexpr size_t WS_ULOC = 906 * MiB;
constexpr size_t WS_END = 938 * MiB;

constexpr int CW_BAR = 4096;

constexpr int RING_OFF = 0, RING_BYTES = 131072;
constexpr int LDSCTL_OFF = RING_BYTES, MISC_OFF = LDSCTL_OFF + 320;
constexpr int LDS_BYTES = 147456;

__device__ __forceinline__ float bflo(unsigned u) { return __builtin_bit_cast(float, u << 16); }
__device__ __forceinline__ float bfhi(unsigned u) { return __builtin_bit_cast(float, u & 0xffff0000u); }
__device__ __forceinline__ float bf2f(unsigned short u) { return __builtin_bit_cast(float, (unsigned)u << 16); }
__device__ __forceinline__ float sigmoidf_(float v) { return __builtin_amdgcn_rcpf(1.0f + __builtin_amdgcn_exp2f(-1.44269504089f * v)); }
__device__ __forceinline__ float wave_sum(float v) {
#pragma unroll
    for (int o = 1; o < 64; o <<= 1) v += __shfl_xor(v, o);
    return v;
}
__device__ __forceinline__ float wave_max(float v) {
#pragma unroll
    for (int o = 1; o < 64; o <<= 1) v = fmaxf(v, __shfl_xor(v, o));
    return v;
}

namespace pg8 {
struct EpiProj {
    static constexpr bool PERM = true, AFTER_DRAIN = false, MID_HOOK = false;
    bf16_t* PA; bf16_t* PB; float* GLR;
    __device__ __forceinline__ void operator()(const f32x4 (&acc)[2][2][4][2], const Unit& u, int wr, int wc, int fr, int fq) const {
        const int pn = u.pn, row0 = u.pm * BM + wr * 64 + fr;
        if (pn < 20) {
            const float sc = pn < 2 ? 0.08838834764831845f : 1.0f;
            const int col0 = pn * BM + wc * 32 + 8 * fq;
#pragma unroll
            for (int ai = 0; ai < 2; ++ai)
#pragma unroll
                for (int m = 0; m < 4; ++m) { bf16_t* rowp = PA + (size_t)(row0 + ai * HALF + m * 16) * NPA + col0;
#pragma unroll
                    for (int bj = 0; bj < 2; ++bj) { const f32x4 v0 = acc[ai][bj][m][0] * sc, v1 = acc[ai][bj][m][1] * sc;
                        u32x4 w; w.x = cvt_pk_bf16(v0[0], v0[1]); w.y = cvt_pk_bf16(v0[2], v0[3]); w.z = cvt_pk_bf16(v1[0], v1[1]); w.w = cvt_pk_bf16(v1[2], v1[3]);
                        *(u32x4*)(rowp + bj * HALF) = w; } }
        } else if (pn < 44) {
            const bool is_silu = pn < 28;
            const int col0 = (pn - 20) * BM + wc * 32 + 8 * fq;
#pragma unroll
            for (int ai = 0; ai < 2; ++ai)
#pragma unroll
                for (int m = 0; m < 4; ++m) { bf16_t* rowp = PB + (size_t)(row0 + ai * HALF + m * 16) * NPB + col0;
#pragma unroll
                    for (int bj = 0; bj < 2; ++bj) { float v[8];
#pragma unroll
                        for (int i = 0; i < 4; ++i) { v[i] = acc[ai][bj][m][0][i]; v[4 + i] = acc[ai][bj][m][1][i]; }
#pragma unroll
                        for (int i = 0; i < 8; ++i) { const float s = sigmoidf_(v[i]); v[i] = is_silu ? v[i] * s : s; }
                        u32x4 w; w.x = cvt_pk_bf16(v[0], v[1]); w.y = cvt_pk_bf16(v[2], v[3]); w.z = cvt_pk_bf16(v[4], v[5]); w.w = cvt_pk_bf16(v[6], v[7]);
                        *(u32x4*)(rowp + bj * HALF) = w; } }
        } else {
            if (wc == 0 && fq < 2) {
#pragma unroll
                for (int ai = 0; ai < 2; ++ai)
#pragma unroll
                    for (int m = 0; m < 4; ++m) { float* rowp = GLR + (size_t)(row0 + ai * HALF + m * 16) * 16 + 8 * fq;
                        *(f32x4*)(rowp) = acc[ai][0][m][0]; *(f32x4*)(rowp + 4) = acc[ai][0][m][1]; }
            }
        }
    }
};
struct EpiMerge {
    static constexpr bool PERM = true, AFTER_DRAIN = false, MID_HOOK = true;
    const bf16_t* PB; bf16_t* MG;
    __device__ __forceinline__ void mid(f32x4 (&acc)[2][2][4][2], const Unit& u, int wr, int wc, int fr, int fq) const {
        int opq; asm volatile("v_mov_b32 %0, 0" : "=v"(opq));
        const int row0 = u.pm * BM + wr * 64 + fr + opq, col0 = u.pn * BM + wc * 32 + 8 * fq;
#pragma unroll
        for (int ai = 0; ai < 2; ++ai)
#pragma unroll
            for (int m = 0; m < 4; ++m) { const bf16_t* rowp = PB + (size_t)(row0 + ai * HALF + m * 16) * NPB + col0;
#pragma unroll
                for (int bj = 0; bj < 2; ++bj) {
                    const u32x4 a = *(const u32x4*)(rowp + B_GA + bj * HALF), b = *(const u32x4*)(rowp + B_GB + bj * HALF);
                    f32x4 r0, r1;
                    r0[0] = bflo(a.x) * __builtin_amdgcn_rcpf(bflo(b.x)); r0[1] = bfhi(a.x) * __builtin_amdgcn_rcpf(bfhi(b.x));
                    r0[2] = bflo(a.y) * __builtin_amdgcn_rcpf(bflo(b.y)); r0[3] = bfhi(a.y) * __builtin_amdgcn_rcpf(bfhi(b.y));
                    r1[0] = bflo(a.z) * __builtin_amdgcn_rcpf(bflo(b.z)); r1[1] = bfhi(a.z) * __builtin_amdgcn_rcpf(bfhi(b.z));
                    r1[2] = bflo(a.w) * __builtin_amdgcn_rcpf(bflo(b.w)); r1[3] = bfhi(a.w) * __builtin_amdgcn_rcpf(bfhi(b.w));
                    acc[ai][bj][m][0] = acc[ai][bj][m][0] * r0; acc[ai][bj][m][1] = acc[ai][bj][m][1] * r1; }
                __builtin_amdgcn_sched_barrier(0); }
    }
    __device__ __forceinline__ void operator()(const f32x4 (&acc)[2][2][4][2], const Unit& u, int wr, int wc, int fr, int fq) const {
        const int row0 = u.pm * BM + wr * 64 + fr, col0 = u.pn * BM + wc * 32 + 8 * fq;
#pragma unroll
        for (int ai = 0; ai < 2; ++ai)
#pragma unroll
            for (int m = 0; m < 4; ++m) { const size_t row = (size_t)(row0 + ai * HALF + m * 16); const bf16_t* gp = PB + row * NPB + B_GB + col0; bf16_t* op = MG + row * DM + col0;
#pragma unroll
                for (int bj = 0; bj < 2; ++bj) { const u32x4 b = *(const u32x4*)(gp + bj * HALF);
                    const f32x4 v0 = acc[ai][bj][m][0], v1 = acc[ai][bj][m][1];
                    u32x4 w; w.x = cvt_pk_bf16(v0[0] * bflo(b.x), v0[1] * bfhi(b.x)); w.y = cvt_pk_bf16(v0[2] * bflo(b.y), v0[3] * bfhi(b.y));
                    w.z = cvt_pk_bf16(v1[0] * bflo(b.z), v1[1] * bfhi(b.z)); w.w = cvt_pk_bf16(v1[2] * bflo(b.w), v1[3] * bfhi(b.w));
                    *(u32x4*)(op + bj * HALF) = w; } }
    }
};
struct EpiOut {
    static constexpr bool PERM = true, AFTER_DRAIN = false, MID_HOOK = false;
    const float* X; float* O;
    __device__ __forceinline__ void operator()(const f32x4 (&acc)[2][2][4][2], const Unit& u, int wr, int wc, int fr, int fq) const {
        const int row0 = u.pm * BM + wr * 64 + fr, col0 = u.pn * BM + wc * 32 + 8 * fq;
#pragma unroll
        for (int ai = 0; ai < 2; ++ai)
#pragma unroll
            for (int m = 0; m < 4; ++m) { const size_t off = (size_t)(row0 + ai * HALF + m * 16) * DM + col0;
#pragma unroll
                for (int bj = 0; bj < 2; ++bj) { const float* xp = X + off + bj * HALF; float* op = O + off + bj * HALF;
                    const f32x4 x0 = *(const f32x4*)xp, x1 = *(const f32x4*)(xp + 4);
                    *(f32x4*)op = x0 + acc[ai][bj][m][0]; *(f32x4*)(op + 4) = x1 + acc[ai][bj][m][1]; } }
    }
};
}

struct Frame {
    LAS unsigned char* lds;
    int tid, lane, wave, vcu, G;
    const float *x, *norm_g, *w_in, *w_gate, *b_gate, *gla_g, *qn_g, *kn_g, *w_bg, *w_bm, *w_out;
    float* out;
    bf16 *WIN, *WCAT, *WOUT, *XN, *ACAT, *PA, *PB, *MG;
    float *GLR, *KMEAN, *OG;
    int* SEL;
};

__device__ __forceinline__ int win_src_col(int d) {
    if (d < 2048) return d;
    if (d < 5120) return d - 2048 + 3088;
    if (d < 6144) return d - 5120 + 2064;
    if (d < 7168) return d - 6144 + 6160;
    if (d < 11264) return d - 7168 + 7184;
    if (d < 11280) return d - 11264 + 2048;
    return -1;
}
template <bool MAPPED>
__device__ __forceinline__ void transpose_item(const float* W, int Nsrc, bf16* WT, int ldk, int koff, int k0, int n0, LAS float* scr, int lane) {
    const int nn = n0 + (lane & 31);
    const int sc = MAPPED ? win_src_col(nn) : nn;
#pragma unroll 8
    for (int i = 0; i < 32; ++i) { const int kk = 2 * i + (lane >> 5); scr[kk * 33 + (lane & 31)] = sc >= 0 ? W[(size_t)(k0 + kk) * Nsrc + sc] : 0.f; }
    LDS_WAIT(); asm volatile("" ::: "memory");
    const int c = lane & 7;
#pragma unroll
    for (int j = 0; j < 4; ++j) { const int n = (lane >> 3) + 8 * j; const LAS float* s = scr + (8 * c) * 33 + n;
        v4u o; o.x = pk2(s[0 * 33], s[1 * 33]); o.y = pk2(s[2 * 33], s[3 * 33]); o.z = pk2(s[4 * 33], s[5 * 33]); o.w = pk2(s[6 * 33], s[7 * 33]);
        *(GAS v4u*)(WT + (size_t)(n0 + n) * ldk + koff + k0 + 8 * c) = o; }
    LDS_WAIT(); asm volatile("" ::: "memory");
}
__device__ __forceinline__ void p0_prologue(Frame& F) {
    LAS float* scr = (LAS float*)(F.lds + RING_OFF + F.wave * 16384);
    const int gw = F.vcu * NWAVES + F.wave, NGW = F.G * NWAVES;
    constexpr int NB_IN = 11296 / 32, I_IN = (DM / 64) * NB_IN;
    constexpr int I_BG = (1024 / 64) * (DM / 32), I_OUT = (DM / 64) * (DM / 32);
    constexpr int NITEMS = I_IN + 2 * I_BG + I_OUT;
    for (int it = gw; it < NITEMS; it += NGW) {
        int r = it;
        if (r < I_IN) { const int kb = r / NB_IN, nb = r % NB_IN; transpose_item<true>(F.w_in, NSRC, F.WIN, DM, 0, 64 * kb, 32 * nb, scr, F.lane); continue; } r -= I_IN;
        if (r < I_BG) { const int kb = r / (DM / 32), nb = r % (DM / 32); transpose_item<false>(F.w_bg, DM, F.WCAT, 2048, 0, 64 * kb, 32 * nb, scr, F.lane); continue; } r -= I_BG;
        if (r < I_BG) { const int kb = r / (DM / 32), nb = r % (DM / 32); transpose_item<false>(F.w_bm, DM, F.WCAT, 2048, 1024, 64 * kb, 32 * nb, scr, F.lane); continue; } r -= I_BG;
        { const int kb = r / (DM / 32), nb = r % (DM / 32); transpose_item<false>(F.w_out, DM, F.WOUT, DM, 0, 64 * kb, 32 * nb, scr, F.lane); }
    }
    f32x4 g[8];
#pragma unroll
    for (int j = 0; j < 8; ++j) g[j] = ((const GAS f32x4*)F.norm_g)[64 * j + F.lane];
    for (int m = gw; m < T; m += NGW) {
        const GAS f32x4* xr = (const GAS f32x4*)(F.x + (size_t)m * DM) + F.lane;
        f32x4 v[8]; float s = 0.f;
#pragma unroll
        for (int j = 0; j < 8; ++j) { v[j] = xr[64 * j]; s += (v[j].x * v[j].x + v[j].y * v[j].y) + (v[j].z * v[j].z + v[j].w * v[j].w); }
        const float r = 1.0f / sqrtf(wave_sum(s) * (1.0f / DM) + NORM_EPS);
        GAS unsigned long long* o8 = (GAS unsigned long long*)(F.XN + (size_t)m * DM) + F.lane;
#pragma unroll
        for (int j = 0; j < 8; ++j) { const f32x4 y = v[j] * r * g[j]; o8[64 * j] = (unsigned long long)pk2(y.x, y.y) | ((unsigned long long)pk2(y.z, y.w) << 32); }
    }
}

__device__ __forceinline__ void m0_qknorm(Frame& F) {
    LAS float* red = (LAS float*)(F.lds);
    const int rg = F.tid >> 4, l16 = F.tid & 15;
    for (int item = F.vcu; item < BATCH * NBLK * MH; item += F.G) {
        const int h = item % MH, blk = (item / MH) % NBLK, b = item / (MH * NBLK);
        float gq[8], gk[8], cs[8];
#pragma unroll
        for (int e = 0; e < 8; ++e) { gq[e] = F.qn_g[l16 * 8 + e]; gk[e] = F.kn_g[l16 * 8 + e]; cs[e] = 0.f; }
        for (int it = 0; it < 8; ++it) {
            const size_t row = (size_t)b * SEQ + blk * MBLK + it * 32 + rg;
#pragma unroll
            for (int w = 0; w < 2; ++w) {
                bf16* p = F.PA + row * NPA + (w ? A_MK : A_MQ) + h * MDH + l16 * 8;
                const v4u raw = *(const GAS v4u*)p; float v[8];
                v[0] = bflo(raw.x); v[1] = bfhi(raw.x); v[2] = bflo(raw.y); v[3] = bfhi(raw.y); v[4] = bflo(raw.z); v[5] = bfhi(raw.z); v[6] = bflo(raw.w); v[7] = bfhi(raw.w);
                float ss = 0.f;
#pragma unroll
                for (int e = 0; e < 8; ++e) ss += v[e] * v[e];
                ss += __shfl_xor(ss, 1); ss += __shfl_xor(ss, 2); ss += __shfl_xor(ss, 4); ss += __shfl_xor(ss, 8);
                const float r = 1.0f / sqrtf(ss * (1.0f / MDH) + NORM_EPS);
#pragma unroll
                for (int e = 0; e < 8; ++e) { v[e] = v[e] * r * (w ? gk[e] : gq[e]); if (w) cs[e] += v[e]; }
                v4u o; o.x = pk2(v[0], v[1]); o.y = pk2(v[2], v[3]); o.z = pk2(v[4], v[5]); o.w = pk2(v[6], v[7]);
                *(GAS v4u*)p = o;
            }
        }
#pragma unroll
        for (int e = 0; e < 8; ++e) red[rg * 128 + l16 * 8 + e] = cs[e];
        __syncthreads();
        if (F.tid < 128) { float s = 0.f;
#pragma unroll 8
            for (int r = 0; r < 32; ++r) s += red[r * 128 + F.tid];
            F.KMEAN[((size_t)(b * MH + h) * NBLK + blk) * MDH + F.tid] = s * (1.0f / MBLK); }
        __syncthreads();
    }
}

__device__ __forceinline__ void m1_select(Frame& F) {
    LAS float* km = (LAS float*)(F.lds);
    for (int item = F.vcu; item < BATCH * MH * (SEQ / 512); item += F.G) {
        const int qc = item % (SEQ / 512), h = (item / (SEQ / 512)) % MH, b = item / ((SEQ / 512) * MH);
        __syncthreads();
        for (int i = F.tid; i < NBLK * MDH; i += NWAVES * 64) { const int j = i / MDH, d = i % MDH; km[d * NBLK + j] = F.KMEAN[(size_t)(b * MH + h) * NBLK * MDH + i]; }
        __syncthreads();
        const int t = qc * 512 + F.tid, qb = t / MBLK;
        const bf16* qp = F.PA + ((size_t)b * SEQ + t) * NPA + A_MQ + h * MDH;
        float acc[NBLK];
#pragma unroll
        for (int j = 0; j < NBLK; ++j) acc[j] = 0.f;
        for (int c = 0; c < 16; ++c) {
            const v4u raw = *(const GAS v4u*)(qp + c * 8); float q[8];
            q[0] = bflo(raw.x); q[1] = bfhi(raw.x); q[2] = bflo(raw.y); q[3] = bfhi(raw.y); q[4] = bflo(raw.z); q[5] = bfhi(raw.z); q[6] = bflo(raw.w); q[7] = bfhi(raw.w);
#pragma unroll
            for (int e = 0; e < 8; ++e) { const LAS f32x4* kr = (const LAS f32x4*)(km + (c * 8 + e) * NBLK);
#pragma unroll
                for (int j4 = 0; j4 < NBLK / 4; ++j4) { const f32x4 kv = kr[j4];
                    acc[4 * j4 + 0] = fmaf(q[e], kv.x, acc[4 * j4 + 0]); acc[4 * j4 + 1] = fmaf(q[e], kv.y, acc[4 * j4 + 1]);
                    acc[4 * j4 + 2] = fmaf(q[e], kv.z, acc[4 * j4 + 2]); acc[4 * j4 + 3] = fmaf(q[e], kv.w, acc[4 * j4 + 3]); } }
        }
        float b0 = -3.0e38f, b1 = -3.0e38f, b2 = -3.0e38f; int i0 = -1, i1 = -1, i2 = -1;
#pragma unroll
        for (int j = 0; j < NBLK; ++j) {
            const float v = (j < qb) ? acc[j] : -3.0e38f;
            const bool c0 = v > b0, c1 = v > b1, c2 = v > b2;
            b2 = c1 ? b1 : (c2 ? v : b2); i2 = c1 ? i1 : (c2 ? j : i2);
            b1 = c0 ? b0 : (c1 ? v : b1); i1 = c0 ? i0 : (c1 ? j : i1);
            b0 = c0 ? v : b0; i0 = c0 ? j : i0;
        }
        int sel[3] = {i0, i1, i2};
        int4 o; o.x = sel[0]; o.y = sel[1]; o.z = sel[2]; o.w = -1;
        *(int4*)(F.SEL + (((size_t)(b * MH + h) * SEQ + t) * 4)) = o;
    }
}

__device__ __forceinline__ void m2_attn_naive(Frame& F) {
    LAS float* P = (LAS float*)(F.lds) + F.wave * 1024;
    const int gw = F.vcu * NWAVES + F.wave, NGW = F.G * NWAVES;
    for (int item = gw; item < BATCH * MH * SEQ; item += NGW) {
        const int t = item % SEQ, h = (item / SEQ) % MH, b = item / (SEQ * MH);
        const int own = t / MBLK;
        const int4 s4 = *(const int4*)(F.SEL + (((size_t)(b * MH + h) * SEQ + t) * 4));
        unsigned blks = 0u; int nb = 0;
        if (s4.x >= 0) { blks |= (unsigned)s4.x << (8 * nb); ++nb; } if (s4.y >= 0) { blks |= (unsigned)s4.y << (8 * nb); ++nb; } if (s4.z >= 0) { blks |= (unsigned)s4.z << (8 * nb); ++nb; }
        blks |= (unsigned)own << (8 * nb); ++nb;
        const float slope = __builtin_amdgcn_exp2f(-(float)(h + 1));
        const bf16* qp = F.PA + ((size_t)b * SEQ + t) * NPA + A_MQ + h * MDH;
        v4u q[16];
#pragma unroll
        for (int c = 0; c < 16; ++c) q[c] = *(const GAS v4u*)(qp + c * 8);
        float mx = -3.0e38f;
        for (int bi = 0; bi < nb; ++bi) {
            const int blk = (int)((blks >> (8 * bi)) & 0xffu);
            for (int kc = 0; kc < 4; ++kc) {
                const int pos = blk * MBLK + kc * 64 + F.lane;
                const bf16* kp = F.PA + ((size_t)b * SEQ + pos) * NPA + A_MK + h * MDH;
                float s = 0.f;
#pragma unroll
                for (int c = 0; c < 16; ++c) { const v4u kv = *(const GAS v4u*)(kp + c * 8);
                    s += bflo(kv.x) * bflo(q[c].x) + bfhi(kv.x) * bfhi(q[c].x) + bflo(kv.y) * bflo(q[c].y) + bfhi(kv.y) * bfhi(q[c].y)
                       + bflo(kv.z) * bflo(q[c].z) + bfhi(kv.z) * bfhi(q[c].z) + bflo(kv.w) * bflo(q[c].w) + bfhi(kv.w) * bfhi(q[c].w); }
                s = s * 0.08838834764831845f - slope * (float)(t - pos);
                if (pos > t) s = -1.0e30f;
                P[bi * 256 + kc * 64 + F.lane] = s; mx = fmaxf(mx, s);
            }
        }
        mx = wave_max(mx);
        float l = 0.f;
        for (int i = F.lane; i < nb * 256; i += 64) { const float p = __builtin_amdgcn_exp2f((P[i] - mx) * 1.44269504089f); P[i] = p; l += p; }
        l = wave_sum(l);
        LDS_WAIT(); asm volatile("" ::: "memory");
        float o0 = 0.f, o1 = 0.f;
        for (int bi = 0; bi < nb; ++bi) {
            const bf16* vp = F.PA + ((size_t)b * SEQ + (int)((blks >> (8 * bi)) & 0xffu) * MBLK) * NPA + A_MV + h * MDH + 2 * F.lane;
#pragma unroll 8
            for (int k = 0; k < 256; ++k) { const float p = P[bi * 256 + k]; const unsigned vv = *(const GAS unsigned*)(vp + (size_t)k * NPA); o0 = fmaf(p, bflo(vv), o0); o1 = fmaf(p, bfhi(vv), o1); }
        }
        const float inv = 1.0f / l;
        const unsigned gs = *(const GAS unsigned*)(F.PB + ((size_t)b * SEQ + t) * NPB + B_MS + h * MDH + 2 * F.lane);
        *(GAS unsigned*)(F.ACAT + ((size_t)b * SEQ + t) * 2048 + 1024 + h * MDH + 2 * F.lane) = pk2(o0 * inv * bflo(gs), o1 * inv * bfhi(gs));
        LDS_WAIT(); asm volatile("" ::: "memory");
    }
}

__device__ __forceinline__ void gla_naive(Frame& F) {
    LAS float* Wg = (LAS float*)(F.lds);
    LAS float* bg = Wg + 16 * 128;
    LAS float* glr = bg + 128;
    LAS float* aa = glr + 64 * 16;
    LAS float* qq = aa + 64 * 128;
    LAS float* kk = qq + 64 * 128;
    LAS float* vv = kk + 64 * 128;
    for (int item = F.vcu; item < BATCH * GH * (GDV / 8); item += F.G) {
        const int dvs = item % (GDV / 8), h = (item / (GDV / 8)) % GH, b = item / ((GDV / 8) * GH);
        __syncthreads();
        for (int i = F.tid; i < 16 * 128; i += 512) Wg[i] = F.w_gate[(size_t)(i / 128) * GWK + h * GDK + (i % 128)];
        if (F.tid < 128) bg[F.tid] = F.b_gate[h * GDK + F.tid];
        float S0 = 0.f, S1 = 0.f;
        const int dv = dvs * 8 + F.wave;
        for (int c0 = 0; c0 < SEQ; c0 += 64) {
            __syncthreads();
            const size_t rowb = (size_t)b * SEQ + c0;
            for (int i = F.tid; i < 64 * 16; i += 512) glr[i] = F.GLR[rowb * 16 + i];
            for (int i = F.tid; i < 64 * 128; i += 512) { const int r = i >> 7, d = i & 127; const bf16* p = F.PA + (rowb + r) * NPA + h * GDK + d; qq[i] = bf2f(p[A_GQ]); kk[i] = bf2f(p[A_GK]); }
            { const int r = F.tid >> 3, j = F.tid & 7; vv[F.tid] = bf2f(F.PA[(rowb + r) * NPA + A_GV + h * GDV + dvs * 8 + j]); }
            __syncthreads();
            for (int i = F.tid; i < 64 * 128; i += 512) { const int r = i >> 7, d = i & 127; float z = bg[d];
#pragma unroll
                for (int j = 0; j < 16; ++j) z = fmaf(glr[r * 16 + j], Wg[j * 128 + d], z);
                const float ls = fminf(z, 0.f) - log1pf(expf(-fabsf(z)));
                aa[i] = expf(ls * (1.0f / 16.0f)); }
            __syncthreads();
            for (int r = 0; r < 64; ++r) {
                const float v = vv[r * 8 + F.wave];
                S0 = aa[r * 128 + F.lane] * S0 + kk[r * 128 + F.lane] * v;
                S1 = aa[r * 128 + 64 + F.lane] * S1 + kk[r * 128 + 64 + F.lane] * v;
                const float o = wave_sum(qq[r * 128 + F.lane] * S0 + qq[r * 128 + 64 + F.lane] * S1);
                if (F.lane == 0) F.OG[(rowb + r) * GWV + h * GDV + dv] = o;
            }
        }
    }
}
__device__ __forceinline__ void gla_post(Frame& F) {
    const int gw = F.vcu * NWAVES + F.wave, NGW = F.G * NWAVES;
    const f32x4 g = ((const GAS f32x4*)F.gla_g)[F.lane];
    for (int item = gw; item < T * GH; item += NGW) {
        const int h = item % GH; const size_t row = item / GH;
        const f32x4 o = ((const GAS f32x4*)(F.OG + row * GWV + h * GDV))[F.lane];
        const float ss = wave_sum((o.x * o.x + o.y * o.y) + (o.z * o.z + o.w * o.w));
        const float r = 1.0f / sqrtf(ss * (1.0f / GDV) + NORM_EPS);
        const unsigned long long gs = *(const GAS unsigned long long*)(F.PB + row * NPB + B_GS + h * GDV + 4 * F.lane);
        const unsigned lo = (unsigned)gs, hi = (unsigned)(gs >> 32);
        const unsigned long long w = (unsigned long long)pk2(o.x * r * g.x * bflo(lo), o.y * r * g.y * bfhi(lo)) | ((unsigned long long)pk2(o.z * r * g.z * bflo(hi), o.w * r * g.w * bfhi(hi)) << 32);
        *(GAS unsigned long long*)(F.ACAT + row * 2048 + h * GDV + 4 * F.lane) = w;
    }
}


typedef float f32x16 __attribute__((ext_vector_type(16)));
typedef float f32x2 __attribute__((ext_vector_type(2)));
typedef short s16x4 __attribute__((ext_vector_type(4)));
typedef __bf16 bf16x2_t __attribute__((ext_vector_type(2)));
#define MFMA32(a, b, c) __builtin_amdgcn_mfma_f32_32x32x16_bf16((a), (b), (c), 0, 0, 0)
__device__ __forceinline__ unsigned pkbf(float lo, float hi) { f32x2 v; v.x = lo; v.y = hi; return __builtin_bit_cast(unsigned, __builtin_convertvector(v, bf16x2_t)); }
__device__ __forceinline__ unsigned off_b(unsigned row, unsigned ch) { return 256u * row + 16u * (ch ^ (((row & 3u) << 2) | ((row >> 2) & 3u))); }
__device__ __forceinline__ int crow(int reg, int h) { return (reg & 3) + 8 * (reg >> 2) + 4 * h; }
__device__ __forceinline__ bf16x8 tr_frag(LAS unsigned char* tile, int lane, int rowbase, int c) {
    const unsigned h = lane >> 5, blk = (lane >> 4) & 1, q = (lane & 15) >> 2, p = lane & 3;
    const unsigned a0 = off_b(rowbase + 8 * h + q, 4 * c + 2 * blk + (p >> 1)) + 8 * (p & 1);
    const unsigned a1 = off_b(rowbase + 8 * h + 4 + q, 4 * c + 2 * blk + (p >> 1)) + 8 * (p & 1);
    const s16x4 lo = __builtin_amdgcn_ds_read_tr16_b64_v4i16((LAS s16x4*)(tile + a0));
    const s16x4 hi = __builtin_amdgcn_ds_read_tr16_b64_v4i16((LAS s16x4*)(tile + a1));
    return __builtin_shufflevector(lo, hi, 0, 1, 2, 3, 4, 5, 6, 7);
}
__device__ __forceinline__ bf16x8 row_frag(LAS unsigned char* tile, int row, int s, int h) { return *(const LAS bf16x8*)(tile + off_b(row, 2 * s + h)); }
__device__ __forceinline__ bf16x8 perm_frag(LAS unsigned char* tile, int row, int kb, int s, int h) {
    const s16x4 lo = *(const LAS s16x4*)(tile + off_b(row, 4 * kb + 2 * s) + 8 * h);
    const s16x4 hi = *(const LAS s16x4*)(tile + off_b(row, 4 * kb + 2 * s + 1) + 8 * h);
    return __builtin_shufflevector(lo, hi, 0, 1, 2, 3, 4, 5, 6, 7);
}
__device__ __forceinline__ bf16x8 pack_acc(const f32x16& x, int s) {
    v4u p; p.x = pkbf(x[8 * s], x[8 * s + 1]); p.y = pkbf(x[8 * s + 2], x[8 * s + 3]); p.z = pkbf(x[8 * s + 4], x[8 * s + 5]); p.w = pkbf(x[8 * s + 6], x[8 * s + 7]);
    return __builtin_bit_cast(bf16x8, p);
}
constexpr int G_NC = 8, G_NG = (SEQ / 64) / G_NC;

__device__ __forceinline__ void gla_g1(Frame& F, float* DEC, float* DG, float* ULOC) {
    LAS unsigned char* KT = F.lds;
    LAS unsigned char* VT = F.lds + 16384;
    LAS float* glr = (LAS float*)(F.lds + 49152);
    LAS float* Wg = (LAS float*)(F.lds + 53248);
    LAS float* bg = (LAS float*)(F.lds + 61440);
    LAS float* tot = (LAS float*)(F.lds + 62464);
    LAS float* dvec = (LAS float*)(F.lds + 64512);
    const int w = F.wave;
    for (int item = F.vcu; item < BATCH * GH * G_NG; item += F.G) {
        const int g = item % G_NG, hd = (item / G_NG) % GH, b = item / (G_NG * GH);
        const int d = F.tid & 127, qr = F.tid >> 7;
        __syncthreads();
        for (int i = F.tid; i < 16 * 128; i += 512) Wg[i] = F.w_gate[(size_t)(i >> 7) * GWK + hd * GDK + (i & 127)];
        if (F.tid < 128) bg[F.tid] = F.b_gate[hd * GDK + F.tid];
        __syncthreads();
        float wg[16];
#pragma unroll
        for (int j = 0; j < 16; ++j) wg[j] = Wg[j * 128 + d];
        const float bias = bg[d];
        float Dg = 1.0f;
        f32x16 U[4];
#pragma unroll
        for (int mt = 0; mt < 4; ++mt)
#pragma unroll
            for (int i = 0; i < 16; ++i) U[mt][i] = 0.f;
        for (int c = 0; c < G_NC; ++c) {
            const int cc = g * G_NC + c; const size_t rowb = (size_t)b * SEQ + (size_t)cc * 64;
            int lane = F.lane; asm volatile("" : "+v"(lane));
            const int h2 = lane >> 5, r = lane & 31;
            int tido = F.tid; asm volatile("" : "+v"(tido));
            const int d = tido & 127, qr = tido >> 7;
            __syncthreads();
            for (int i = F.tid; i < 64 * 16; i += 512) glr[i] = F.GLR[rowb * 16 + i];
            for (int i = F.tid; i < 2048; i += 512) { const int row = i >> 5, c32 = i & 31;
                const v4u val = *(const GAS v4u*)(F.PA + (rowb + row) * NPA + A_GV + hd * GDV + c32 * 8);
                *(LAS v4u*)(VT + (c32 >> 4) * 16384 + off_b(row, c32 & 15)) = val; }
            __syncthreads();
            float loc[16]; float run = 0.f;
#pragma unroll
            for (int i = 0; i < 16; ++i) { const int row = 16 * qr + i; float z = bias;
#pragma unroll
                for (int j = 0; j < 16; ++j) z = fmaf(glr[row * 16 + j], wg[j], z);
                const float sp = __builtin_amdgcn_logf(1.0f + __builtin_amdgcn_exp2f(-fabsf(z) * 1.44269504089f)) * 0.69314718056f;
                run += (fminf(z, 0.f) - sp) * (1.0f / 16.0f); loc[i] = run; }
            tot[qr * 128 + d] = run;
            __syncthreads();
            float off = 0.f, total = 0.f;
#pragma unroll
            for (int q2 = 0; q2 < 4; ++q2) { const float tq = tot[q2 * 128 + d]; total += tq; off += (q2 < qr) ? tq : 0.f; }
            if (qr == 0) { const float dd = __builtin_amdgcn_exp2f(total * 1.44269504089f); dvec[d] = dd; DEC[((size_t)(b * GH + hd) * (SEQ / 64) + cc) * GDK + d] = dd; Dg *= dd; }
#pragma unroll
            for (int i = 0; i < 16; ++i) { const int row = 16 * qr + i; const float bb = loc[i] + off;
                bf16* p = F.PA + (rowb + row) * NPA + hd * GDK + d;
                const float eb = __builtin_amdgcn_exp2f(bb * 1.44269504089f), ebi = __builtin_amdgcn_exp2f(-bb * 1.44269504089f);
                const float qn = bf2f(p[A_GQ]) * eb, kn = bf2f(p[A_GK]) * ebi;
                const unsigned short kb16 = (unsigned short)f2bf(kn);
                p[A_GQ] = (unsigned short)f2bf(qn); p[A_GK] = kb16;
                *(LAS unsigned short*)(KT + off_b(row, d >> 3) + (d & 7) * 2) = kb16; }
            __syncthreads();
#pragma unroll
            for (int ks = 0; ks < 4; ++ks) { const bf16x8 Bf = tr_frag(VT + (w >> 2) * 16384, lane, 16 * ks, w & 3);
#pragma unroll
                for (int mt = 0; mt < 4; ++mt) { const bf16x8 Af = tr_frag(KT, lane, 16 * ks, mt); U[mt] = MFMA32(Af, Bf, U[mt]); } }
#pragma unroll
            for (int mt = 0; mt < 4; ++mt)
#pragma unroll
                for (int i = 0; i < 16; ++i) U[mt][i] *= dvec[32 * mt + crow(i, h2)];
        }
        float* up = ULOC + (size_t)((b * GH + hd) * G_NG + g) * GDK * GDV;
        { const int h2 = F.lane >> 5, r = F.lane & 31;
#pragma unroll
        for (int mt = 0; mt < 4; ++mt)
#pragma unroll
            for (int i = 0; i < 16; ++i) up[(size_t)(32 * mt + crow(i, h2)) * GDV + 32 * w + r] = U[mt][i]; }
        if (qr == 0) DG[((size_t)(b * GH + hd) * G_NG + g) * GDK + d] = Dg;
    }
}
__device__ __forceinline__ void gla_g2(Frame& F, const float* DG, float* ULOC) {
    const int gt = F.vcu * (NWAVES * 64) + F.tid, NT = F.G * NWAVES * 64;
    for (int e = gt; e < BATCH * GH * GDK * GDV; e += NT) {
        const int bh = e / (GDK * GDV), rem = e % (GDK * GDV), dk = rem / GDV;
        float S = 0.f;
#pragma unroll 8
        for (int g = 0; g < G_NG; ++g) { const size_t idx = (size_t)(bh * G_NG + g) * GDK * GDV + rem; const float u = ULOC[idx]; ULOC[idx] = S; S = fmaf(DG[(size_t)(bh * G_NG + g) * GDK + dk], S, u); }
    }
}
__device__ __forceinline__ void gla_g3(Frame& F, const float* DEC, const float* SST) {
    LAS unsigned char* QT = F.lds;
    LAS unsigned char* KT = F.lds + 16384;
    LAS unsigned char* VT = F.lds + 32768;
    LAS unsigned char* AT = F.lds + 65536;
    LAS float* dvec = (LAS float*)(F.lds + 75776);
    LAS float* red = (LAS float*)(F.lds + 76288);
    const int w = F.wave;
    for (int item = F.vcu; item < BATCH * GH * G_NG; item += F.G) {
        const int g = item % G_NG, hd = (item / G_NG) % GH, b = item / (G_NG * GH);
        f32x16 S[4];
        { const int h2 = F.lane >> 5, r = F.lane & 31; const float* sp = SST + (size_t)((b * GH + hd) * G_NG + g) * GDK * GDV;
#pragma unroll
          for (int mt = 0; mt < 4; ++mt)
#pragma unroll
              for (int i = 0; i < 16; ++i) S[mt][i] = sp[(size_t)(32 * mt + crow(i, h2)) * GDV + 32 * w + r]; }
        for (int c = 0; c < G_NC; ++c) {
            const int cc = g * G_NC + c; const size_t rowb = (size_t)b * SEQ + (size_t)cc * 64;
            int lane = F.lane; asm volatile("" : "+v"(lane));
            const int h2 = lane >> 5, r = lane & 31;
            __syncthreads();
            for (int i = F.tid; i < 1024; i += 512) { const int row = i >> 4, ch = i & 15; const bf16* p = F.PA + (rowb + row) * NPA + hd * GDK + ch * 8;
                *(LAS v4u*)(QT + off_b(row, ch)) = *(const GAS v4u*)(p + A_GQ); *(LAS v4u*)(KT + off_b(row, ch)) = *(const GAS v4u*)(p + A_GK); }
            for (int i = F.tid; i < 2048; i += 512) { const int row = i >> 5, c32 = i & 31;
                *(LAS v4u*)(VT + (c32 >> 4) * 16384 + off_b(row, c32 & 15)) = *(const GAS v4u*)(F.PA + (rowb + row) * NPA + A_GV + hd * GDV + c32 * 8); }
            if (F.tid < 128) dvec[F.tid] = DEC[((size_t)(b * GH + hd) * (SEQ / 64) + cc) * GDK + F.tid];
            __syncthreads();
            if (w < 3) {
                const int tj = w >> 1, ti = (w + 1) >> 1;
                f32x16 a;
#pragma unroll
                for (int i = 0; i < 16; ++i) a[i] = 0.f;
#pragma unroll
                for (int s = 0; s < 8; ++s) a = MFMA32(row_frag(KT, 32 * tj + r, s, h2), row_frag(QT, 32 * ti + r, s, h2), a);
                const int ii = 32 * ti + r;
#pragma unroll
                for (int g4 = 0; g4 < 4; ++g4) { const int j0 = 32 * tj + 8 * g4 + 4 * h2;
                    const float v0 = (j0 + 0 <= ii) ? a[4 * g4 + 0] : 0.f, v1 = (j0 + 1 <= ii) ? a[4 * g4 + 1] : 0.f, v2 = (j0 + 2 <= ii) ? a[4 * g4 + 2] : 0.f, v3 = (j0 + 3 <= ii) ? a[4 * g4 + 3] : 0.f;
                    unsigned long long pk = (unsigned long long)pkbf(v0, v1) | ((unsigned long long)pkbf(v2, v3) << 32);
                    *(LAS unsigned long long*)(AT + ii * 144 + j0 * 2) = pk; }
            }
            __syncthreads();
            f32x16 Z[2];
#pragma unroll
            for (int i = 0; i < 16; ++i) { Z[0][i] = 0.f; Z[1][i] = 0.f; }
#pragma unroll
            for (int mt = 0; mt < 4; ++mt)
#pragma unroll
                for (int s = 0; s < 2; ++s) { const bf16x8 Af = pack_acc(S[mt], s);
                    Z[0] = MFMA32(Af, perm_frag(QT, r, mt, s, h2), Z[0]); Z[1] = MFMA32(Af, perm_frag(QT, 32 + r, mt, s, h2), Z[1]); }
            bf16x8 Vf[4];
#pragma unroll
            for (int ks = 0; ks < 4; ++ks) Vf[ks] = tr_frag(VT + (w >> 2) * 16384, lane, 16 * ks, w & 3);
#pragma unroll
            for (int ks = 0; ks < 4; ++ks) {
                if (ks < 2) Z[0] = MFMA32(Vf[ks], *(const LAS bf16x8*)(AT + r * 144 + (16 * ks + 8 * h2) * 2), Z[0]);
                Z[1] = MFMA32(Vf[ks], *(const LAS bf16x8*)(AT + (32 + r) * 144 + (16 * ks + 8 * h2) * 2), Z[1]); }
#pragma unroll
            for (int tt = 0; tt < 2; ++tt) { float ss = 0.f;
#pragma unroll
                for (int i = 0; i < 16; ++i) ss = fmaf(Z[tt][i], Z[tt][i], ss);
                ss += __shfl_xor(ss, 32);
                if (lane < 32) red[w * 64 + 32 * tt + r] = ss; }
            __syncthreads();
#pragma unroll
            for (int tt = 0; tt < 2; ++tt) { float tsum = 0.f;
#pragma unroll
                for (int w2 = 0; w2 < 8; ++w2) tsum += red[w2 * 64 + 32 * tt + r];
                const float rs = 1.0f / sqrtf(tsum * (1.0f / GDV) + NORM_EPS);
                const size_t row = rowb + 32 * tt + r;
#pragma unroll
                for (int g4 = 0; g4 < 4; ++g4) { const int dv = 32 * w + 8 * g4 + 4 * h2; const f32x4 gg = *(const f32x4*)(F.gla_g + dv);
                    const unsigned long long gs = *(const GAS unsigned long long*)(F.PB + row * NPB + B_GS + hd * GDV + dv); const unsigned lo = (unsigned)gs, hi = (unsigned)(gs >> 32);
                    const unsigned long long o = (unsigned long long)pkbf(Z[tt][4 * g4] * rs * gg.x * bflo(lo), Z[tt][4 * g4 + 1] * rs * gg.y * bfhi(lo))
                                               | ((unsigned long long)pkbf(Z[tt][4 * g4 + 2] * rs * gg.z * bflo(hi), Z[tt][4 * g4 + 3] * rs * gg.w * bfhi(hi)) << 32);
                    *(GAS unsigned long long*)(F.ACAT + row * 2048 + hd * GDV + dv) = o; } }
#pragma unroll
            for (int ks = 0; ks < 4; ++ks)
#pragma unroll
                for (int mt = 0; mt < 4; ++mt) S[mt] = MFMA32(tr_frag(KT, lane, 16 * ks, mt), Vf[ks], S[mt]);
#pragma unroll
            for (int mt = 0; mt < 4; ++mt)
#pragma unroll
                for (int i = 0; i < 16; ++i) S[mt][i] *= dvec[32 * mt + crow(i, h2)];
        }
    }
}

constexpr int N_PHASES = 10;
#ifndef MK_N_LAUNCHES
#define MK_N_LAUNCHES 1
#endif
struct Args { const float* in[11]; float* out; unsigned char* ws; int ph_lo, ph_hi; };
__global__ void __launch_bounds__(NWAVES * 64, 2) mk_fwd(Args args) {
    extern __shared__ __attribute__((aligned(16))) unsigned char lds[];
    Frame F;
    F.lds = (LAS unsigned char*)lds;
    F.tid = threadIdx.x; F.lane = F.tid & 63; F.wave = __builtin_amdgcn_readfirstlane(F.tid >> 6);
    F.G = gridDim.x; { const int bx = blockIdx.x; F.vcu = (F.G % 8 == 0) ? (bx % 8) * (F.G / 8) + bx / 8 : bx; }
    unsigned char* ws = args.ws;
    F.x = args.in[0]; F.norm_g = args.in[1]; F.w_in = args.in[2]; F.w_gate = args.in[3]; F.b_gate = args.in[4]; F.gla_g = args.in[5];
    F.qn_g = args.in[6]; F.kn_g = args.in[7]; F.w_bg = args.in[8]; F.w_bm = args.in[9]; F.w_out = args.in[10]; F.out = args.out;
    F.WIN = (bf16*)(ws + WS_WIN); F.WCAT = (bf16*)(ws + WS_WCAT); F.WOUT = (bf16*)(ws + WS_WOUT); F.XN = (bf16*)(ws + WS_XN); F.ACAT = (bf16*)(ws + WS_ACAT);
    F.PA = (bf16*)(ws + WS_PA); F.PB = (bf16*)(ws + WS_PB); F.MG = (bf16*)(ws + WS_MG);
    F.GLR = (float*)(ws + WS_GLR); F.KMEAN = (float*)(ws + WS_KMEAN); F.OG = args.out; F.SEL = (int*)(ws + WS_SEL);
    volatile LAS unsigned* MISC = (volatile LAS unsigned*)(F.lds + MISC_OFF);
    for (int u = F.tid; u < (LDS_BYTES - LDSCTL_OFF) / 4; u += NWAVES * 64) ((LAS unsigned*)(F.lds + LDSCTL_OFF))[u] = 0u;
    __syncthreads();
    const int lo = args.ph_lo, hi = args.ph_hi;
    XcdBarrier bar; bar.bar = (unsigned*)(ws + WS_CTL) + CW_BAR; bar.x = 0; bar.st = nullptr;
    if (hi - lo > 1) bar = xcd_barrier_post((unsigned*)(ws + WS_CTL) + CW_BAR, MISC + 8);
#ifndef PH_MASK
#define PH_MASK 0x3ff
#endif
#define IN(k) (((PH_MASK >> (k)) & 1) && lo <= (k) && (k) < hi)
#define SEAM(k) do { if (IN(k) && IN((k) + 1)) xcd_barrier(bar); } while (0)

    if (IN(0)) { p0_prologue(F); } SEAM(0);
    if (IN(1)) {
        pg8::Gemm g{F.XN, F.WIN, T, NP, DM}; pg8::StaticOrder S; S.init(T, NP, F.G, (int)blockIdx.x);
        pg8::EpiProj E{F.PA, F.PB, F.GLR};
        pg8::gemm_phase<pg8::EpiProj, pg8::StaticOrder, true, true>(F.lds + RING_OFF, g, S, E);
    } SEAM(1);
    if (IN(2)) { m0_qknorm(F); } SEAM(2);
    if (IN(3)) { m1_select(F); } SEAM(3);
    if (IN(4)) { m2_attn_naive(F); } SEAM(4);
    if (IN(5)) { gla_g1(F, (float*)(ws + WS_DEC), (float*)(ws + WS_DG), (float*)(ws + WS_ULOC)); } SEAM(5);
    if (IN(6)) { gla_g2(F, (const float*)(ws + WS_DG), (float*)(ws + WS_ULOC)); } SEAM(6);
    if (IN(7)) { gla_g3(F, (const float*)(ws + WS_DEC), (const float*)(ws + WS_ULOC)); } SEAM(7);
    if (IN(8)) {
        pg8::Gemm g{F.ACAT, F.WCAT, T, DM, 2048}; pg8::StaticOrder S; S.init(T, DM, F.G, (int)blockIdx.x);
        pg8::EpiMerge E{F.PB, F.MG};
        pg8::gemm_phase<pg8::EpiMerge, pg8::StaticOrder, true, true>(F.lds + RING_OFF, g, S, E);
    } SEAM(8);
    if (IN(9)) {
        pg8::Gemm g{F.MG, F.WOUT, T, DM, DM}; pg8::StaticOrder S; S.init(T, DM, F.G, (int)blockIdx.x);
        pg8::EpiOut E{F.x, F.out};
        pg8::gemm_phase<pg8::EpiOut, pg8::StaticOrder, true, true>(F.lds + RING_OFF, g, S, E);
    }
#undef IN
#undef SEAM
}

extern "C" void kernel_launch(void* const* d_in, const int* in_sizes, int n_in, void* d_out, int out_size, void* d_ws, size_t ws_size, hipStream_t stream) {
    static int grid = 0;
    if (grid == 0) {
        if (n_in != 11 || in_sizes[0] != T * DM || out_size != T * DM || ws_size < WS_END) { fprintf(stderr, "kernel_launch: unexpected shapes (n_in %d, in0 %d, out %d, ws %zu)\n", n_in, n_in > 0 ? in_sizes[0] : -1, out_size, ws_size); grid = -1; return; }
        int dev = 0, cus = 0, per_cu = 0;
        if (hipGetDevice(&dev) != hipSuccess || hipDeviceGetAttribute(&cus, hipDeviceAttributeMultiprocessorCount, dev) != hipSuccess) { grid = -1; return; }
        if (hipFuncSetAttribute((const void*)mk_fwd, hipFuncAttributeMaxDynamicSharedMemorySize, LDS_BYTES) != hipSuccess) { fprintf(stderr, "kernel_launch: hipFuncSetAttribute failed\n"); grid = -1; return; }
        if (hipOccupancyMaxActiveBlocksPerMultiprocessor(&per_cu, (const void*)mk_fwd, NWAVES * 64, LDS_BYTES) != hipSuccess || per_cu < 1) { fprintf(stderr, "kernel_launch: occupancy query says %d blocks per CU\n", per_cu); per_cu = 1; }
        (void)hipGetLastError();
        grid = cus;
    }
    if (grid < 0) return;
    (void)hipMemsetAsync((char*)d_ws + WS_CTL, 0, CTL_ZERO_BYTES, stream);
    Args a{};
    for (int i = 0; i < 11; ++i) a.in[i] = (const float*)d_in[i];
    a.out = (float*)d_out; a.ws = (unsigned char*)d_ws;
    constexpr int NL = MK_N_LAUNCHES;
    for (int li = 0; li < NL; ++li) {
        a.ph_lo = (NL == 1) ? 0 : li; a.ph_hi = (NL == 1) ? N_PHASES : li + 1;
        void* kargs[] = {(void*)&a};
        hipError_t e = hipLaunchCooperativeKernel((const void*)mk_fwd, dim3(grid), dim3(NWAVES * 64), kargs, LDS_BYTES, stream);
        if (e != hipSuccess) { fprintf(stderr, "kernel_launch: cooperative launch failed: %s (grid %d)\n", hipGetErrorString(e), grid); (void)hipGetLastError(); }
    }
}
```

```cpp
#include <hip/hip_runtime.h>
#include <cstdio>
#include <cstdint>
namespace pg8 {
#define PG8_LAS __attribute__((address_space(3)))
typedef unsigned short bf16_t;
typedef short bf16x8 __attribute__((ext_vector_type(8)));
typedef float f32x4 __attribute__((ext_vector_type(4)));
typedef unsigned u32x4 __attribute__((ext_vector_type(4)));
constexpr int BM = 256, BK = 64, HALF = 128, HTB = HALF * BK * 2  , STAGE_BYTES = 8 * HTB, NXCD = 8, WGM = 8;

__host__ __device__ __forceinline__ int lds_byte(int r, int c) { const int st = (r >> 4) * 2 + (c >> 5), rr = r & 15, cc = c & 31, ob = rr * 64 + cc * 2; return st * 1024 + (ob ^ (((ob >> 9) & 1) << 5)); }
__host__ __device__ __forceinline__ void stage_rc(int b, int& R, int& C) { const int st = b / 1024, sb = b % 1024, swz = sb ^ (((sb >> 9) & 1) << 5); R = (st >> 1) * 16 + swz / 64; C = (st & 1) * 32 + (swz % 64) / 2; }
__host__ __device__ __forceinline__ int perm32(int rho) { const int n = rho >> 4, i = rho & 15; return 8 * (i >> 2) + 4 * n + (i & 3); }

struct Unit { int pm, pn; };
struct Gemm { const bf16_t* A; const bf16_t* Bt; int M, N, K; };

struct StaticOrder {
    int nM, nN, nwg, G, c;
    __host__ __device__ void init(int M, int N, int G_, int c_) { nM = M / BM; nN = N / BM; nwg = nM * nN; G = G_; c = c_; }
    __host__ __device__ bool next(int i, Unit& u) const {
        const long L = (long)i * G + c; if (L >= nwg) return false;
        int wgid = (int)L; { const int q = nwg / NXCD, r = nwg % NXCD, xcd = wgid % NXCD, off = wgid / NXCD; wgid = (xcd < r ? xcd * (q + 1) : r * (q + 1) + (xcd - r) * q) + off; }
        const int nig = WGM * nN, gid = wgid / nig, fm = gid * WGM, gsz = (nM - fm) < WGM ? (nM - fm) : WGM;
        u.pm = fm + ((wgid % nig) % gsz); u.pn = (wgid % nig) / gsz; return true;
    }
    __device__ __forceinline__ void a_ready(const Unit&) const {}
    __device__ __forceinline__ void done(const Unit&) const {}
};

__device__ __forceinline__ unsigned cvt_pk_bf16(float lo, float hi) { unsigned r; asm volatile("v_cvt_pk_bf16_f32 %0, %1, %2" : "=v"(r) : "v"(lo), "v"(hi)); return r; }

template <class Epi, class Sched, bool ALIGN_EPI = false, bool SP2 = false>
__device__ __forceinline__ void gemm_phase(PG8_LAS unsigned char* lds, const Gemm g, const Sched& S, const Epi& E) {
    const int tid = threadIdx.x, wid = __builtin_amdgcn_readfirstlane(tid >> 6), lane = tid & 63, wr = wid >> 2, wc = wid & 3, fr = lane & 15, fq = lane >> 4;
    const int K = g.K, nt = K / BK;
    unsigned voffA[2], voffB[2];
#pragma unroll
    for (int i = 0; i < 2; ++i) { int R, C; stage_rc(tid * 16 + i * 8192, R, C); const int Rb = Epi::PERM ? ((R & ~31) + perm32(R & 31)) : R;
        voffA[i] = (unsigned)(R * K + C) * 2u; voffB[i] = (unsigned)(Rb * K + C) * 2u; }
    const size_t kstep = (size_t)(BK * 2);
    const size_t hstep = (size_t)HALF * K * 2;
    const size_t tstep = 2 * hstep;
    const unsigned ldsw = (unsigned)wid * 1024u;
    const int aoff = lds_byte(wr * 64 + fr, fq * 8), boff = lds_byte(wc * 32 + fr, fq * 8);
#define PG8_SA(b, h) (((b) * 2 + (h)) * HTB)
#define PG8_SB(b, h) ((4 + (b) * 2 + (h)) * HTB)
#define PG8_STAGE(bufoff, gbase, voff) do { _Pragma("unroll") for (int _i = 0; _i < 2; ++_i) \
        __builtin_amdgcn_global_load_lds((const unsigned*)((const char*)(gbase) + (voff)[_i]), (PG8_LAS unsigned*)(lds + (bufoff) + ldsw + _i * 8192), 16, 0, 0); } while (0)
#define PG8_LDA(dst, b, h) do { _Pragma("unroll") for (int m = 0; m < 4; ++m) _Pragma("unroll") for (int k = 0; k < 2; ++k) dst[m][k] = *(const PG8_LAS bf16x8*)(lds + PG8_SA(b, h) + aoff + m * 2048 + k * 1024); } while (0)
#define PG8_LDB(dst, b, h) do { _Pragma("unroll") for (int n = 0; n < 2; ++n) _Pragma("unroll") for (int k = 0; k < 2; ++k) dst[n][k] = *(const PG8_LAS bf16x8*)(lds + PG8_SB(b, h) + boff + n * 2048 + k * 1024); } while (0)
#define PG8_MMA(ai, bj, At, Bt) do { __builtin_amdgcn_s_setprio(1); _Pragma("unroll") for (int m = 0; m < 4; ++m) _Pragma("unroll") for (int n = 0; n < 2; ++n) _Pragma("unroll") for (int k = 0; k < 2; ++k) \
        acc[ai][bj][m][n] = __builtin_amdgcn_mfma_f32_16x16x32_bf16(Bt[n][k], At[m][k], acc[ai][bj][m][n], 0, 0, 0); __builtin_amdgcn_s_setprio(0); } while (0)
#define PG8_WAIT_V(n) asm volatile("s_waitcnt vmcnt(" #n ")" ::: "memory")
#define PG8_WAIT_L(n) asm volatile("s_waitcnt lgkmcnt(" #n ")" ::: "memory")
#define PG8_BAR __builtin_amdgcn_s_barrier()
#define PG8_SCHED __builtin_amdgcn_sched_barrier(0)
    Unit cur, nxt; int ui = 0;
    if (!S.next(0, cur)) return;
    f32x4 acc[2][2][4][2];
#pragma unroll
    for (int a = 0; a < 2; ++a)
#pragma unroll
        for (int b = 0; b < 2; ++b)
#pragma unroll
            for (int m = 0; m < 4; ++m)
#pragma unroll
                for (int n = 0; n < 2; ++n) acc[a][b][m][n] = (f32x4){0.f, 0.f, 0.f, 0.f};
    bf16x8 At[4][2], B0[2][2], B1[2][2];
    const char* cA = (const char*)g.A + (size_t)cur.pm * tstep; const char* cB = (const char*)g.Bt + (size_t)cur.pn * tstep;
    S.a_ready(cur);
    if constexpr (SP2) {
        PG8_STAGE(PG8_SB(0, 0), cB, voffB); PG8_STAGE(PG8_SB(0, 1), cB + hstep, voffB); PG8_STAGE(PG8_SA(0, 0), cA, voffA); PG8_STAGE(PG8_SA(0, 1), cA + hstep, voffA);
        if (wr == 1) PG8_BAR;
        PG8_WAIT_V(2); PG8_BAR;
        PG8_STAGE(PG8_SB(1, 0), cB + kstep, voffB); PG8_STAGE(PG8_SA(1, 0), cA + kstep, voffA); PG8_STAGE(PG8_SB(1, 1), cB + hstep + kstep, voffB);
        PG8_WAIT_V(6); PG8_BAR;
    } else {
        PG8_STAGE(PG8_SB(0, 0), cB, voffB); PG8_STAGE(PG8_SA(0, 0), cA, voffA); PG8_STAGE(PG8_SB(0, 1), cB + hstep, voffB); PG8_STAGE(PG8_SA(0, 1), cA + hstep, voffA);
        if (wr == 1) PG8_BAR;
        PG8_WAIT_V(4); PG8_BAR;
        PG8_STAGE(PG8_SB(1, 0), cB + kstep, voffB); PG8_STAGE(PG8_SA(1, 0), cA + kstep, voffA); PG8_STAGE(PG8_SB(1, 1), cB + hstep + kstep, voffB);
        PG8_WAIT_V(6); PG8_BAR;
    }
    for (;;) {
        const bool has_next = S.next(ui + 1, nxt);
        const char* nA = has_next ? (const char*)g.A + (size_t)nxt.pm * tstep : cA; const char* nB = has_next ? (const char*)g.Bt + (size_t)nxt.pn * tstep : cB;
        for (int t = 0; t < nt; t += 2) {
            if constexpr (Epi::MID_HOOK) { if (t == nt / 2) E.mid(acc, cur, wr, wc, fr, fq); }
            const bool last = (t == nt - 2);
            const char* a1 = cA + (size_t)(t + 1) * kstep;
            const char* a2 = last ? nA : cA + (size_t)(t + 2) * kstep; const char* b2 = last ? nB : cB + (size_t)(t + 2) * kstep;
            const char* a3 = a2 + kstep; const char* b3 = b2 + kstep;
            if (last && has_next) S.a_ready(nxt);
            if constexpr (SP2) {
            PG8_LDB(B0, 0, 0); PG8_LDB(B1, 0, 1); PG8_SCHED; PG8_LDA(At, 0, 0); PG8_STAGE(PG8_SA(1, 1), a1 + hstep, voffA);
            PG8_WAIT_V(8); PG8_WAIT_L(0); PG8_BAR; PG8_MMA(0, 0, At, B0); PG8_MMA(0, 1, At, B1); PG8_BAR; PG8_SCHED;
            PG8_LDA(At, 0, 1); PG8_STAGE(PG8_SB(0, 0), b2, voffB); PG8_STAGE(PG8_SB(0, 1), b2 + hstep, voffB); PG8_STAGE(PG8_SA(0, 0), a2, voffA);
            PG8_WAIT_V(8); PG8_WAIT_L(0); PG8_BAR; PG8_MMA(1, 0, At, B0); PG8_MMA(1, 1, At, B1); PG8_BAR; PG8_SCHED;
            PG8_LDB(B0, 1, 0); PG8_LDB(B1, 1, 1); PG8_SCHED; PG8_LDA(At, 1, 0); PG8_STAGE(PG8_SA(0, 1), a2 + hstep, voffA);
            PG8_WAIT_V(8); PG8_WAIT_L(0); PG8_BAR; PG8_MMA(0, 0, At, B0); PG8_MMA(0, 1, At, B1); PG8_BAR; PG8_SCHED;
            PG8_LDA(At, 1, 1); PG8_STAGE(PG8_SB(1, 0), b3, voffB); PG8_STAGE(PG8_SB(1, 1), b3 + hstep, voffB); PG8_STAGE(PG8_SA(1, 0), a3, voffA);
            PG8_WAIT_V(8); PG8_WAIT_L(0); PG8_BAR; PG8_MMA(1, 0, At, B0); PG8_MMA(1, 1, At, B1); PG8_BAR; PG8_SCHED;
            } else {
            PG8_LDB(B0, 0, 0); PG8_SCHED; PG8_LDA(At, 0, 0); PG8_STAGE(PG8_SA(1, 1), a1 + hstep, voffA);
            PG8_WAIT_L(8); PG8_BAR; PG8_WAIT_L(0); PG8_MMA(0, 0, At, B0); PG8_BAR; PG8_SCHED;
            PG8_LDB(B1, 0, 1); PG8_STAGE(PG8_SB(0, 0), b2, voffB);
            PG8_BAR; PG8_WAIT_L(0); PG8_MMA(0, 1, At, B1); PG8_BAR;
            PG8_LDA(At, 0, 1); PG8_STAGE(PG8_SA(0, 0), a2, voffA);
            PG8_BAR; PG8_WAIT_L(0); PG8_MMA(1, 0, At, B0); PG8_BAR; PG8_SCHED;
            PG8_STAGE(PG8_SB(0, 1), b2 + hstep, voffB);
            PG8_WAIT_V(6); PG8_BAR; PG8_MMA(1, 1, At, B1); PG8_BAR;
            PG8_LDB(B0, 1, 0); PG8_SCHED; PG8_LDA(At, 1, 0); PG8_STAGE(PG8_SA(0, 1), a2 + hstep, voffA);
            PG8_WAIT_L(8); PG8_BAR; PG8_WAIT_L(0); PG8_MMA(0, 0, At, B0); PG8_BAR; PG8_SCHED;
            PG8_LDB(B1, 1, 1); PG8_STAGE(PG8_SB(1, 0), b3, voffB);
            PG8_BAR; PG8_WAIT_L(0); PG8_MMA(0, 1, At, B1); PG8_BAR;
            PG8_LDA(At, 1, 1); PG8_STAGE(PG8_SA(1, 0), a3, voffA);
            PG8_BAR; PG8_WAIT_L(0); PG8_MMA(1, 0, At, B0); PG8_BAR; PG8_SCHED;
            PG8_STAGE(PG8_SB(1, 1), b3 + hstep, voffB);
            PG8_WAIT_V(6); PG8_BAR; PG8_MMA(1, 1, At, B1); PG8_BAR;
            }
        }
        if constexpr (ALIGN_EPI) { if (wr == 0) PG8_BAR; }
        if constexpr (!Epi::AFTER_DRAIN) { E(acc, cur, wr, wc, fr, fq); S.done(cur); }
        if (!has_next) break;
#pragma unroll
        for (int a = 0; a < 2; ++a)
#pragma unroll
            for (int b = 0; b < 2; ++b)
#pragma unroll
                for (int m = 0; m < 4; ++m)
#pragma unroll
                    for (int n = 0; n < 2; ++n) acc[a][b][m][n] = (f32x4){0.f, 0.f, 0.f, 0.f};
        cur = nxt; cA = nA; cB = nB; ++ui;
        if constexpr (ALIGN_EPI) { if (wr == 1) PG8_BAR; }
    }
    PG8_WAIT_V(0);
    if constexpr (!ALIGN_EPI) { if (wr == 0) PG8_BAR; }
    PG8_BAR;
    if constexpr (Epi::AFTER_DRAIN) { E.fused(acc, cur, wr, wc, fr, fq, lds, wid, lane); S.done(cur); }
#undef PG8_SA
#undef PG8_SB
#undef PG8_STAGE
#undef PG8_LDA
#undef PG8_LDB
#undef PG8_MMA
#undef PG8_WAIT_V
#undef PG8_WAIT_L
#undef PG8_BAR
#undef PG8_SCHED
}
}
#define GAS __attribute__((address_space(1)))
#define LAS __attribute__((address_space(3)))
typedef unsigned short bf16;
typedef unsigned v4u __attribute__((ext_vector_type(4)));
typedef float f32x4 __attribute__((ext_vector_type(4)));
typedef short bf16x8 __attribute__((ext_vector_type(8)));
typedef GAS unsigned gu32;
typedef GAS unsigned long long gu64;
#define RLX_AGENT __ATOMIC_RELAXED, __HIP_MEMORY_SCOPE_AGENT
#define LDS_WAIT() asm volatile("s_waitcnt lgkmcnt(0)" ::: "memory")
#define VM_WAIT() asm volatile("s_waitcnt vmcnt(0)" ::: "memory")
__device__ __forceinline__ unsigned long long rt() { return __builtin_amdgcn_s_memrealtime(); }
__device__ __forceinline__ unsigned f2bf(float f) { unsigned u = __builtin_bit_cast(unsigned, f); return (u + 0x7fffu + ((u >> 16) & 1u)) >> 16; }
__device__ __forceinline__ unsigned pk2(float lo, float hi) { return f2bf(lo) | (f2bf(hi) << 16); }

#define XB_TMO      128
#define XB_XCNT(j)  (256  + 64 * (j))
#define XB_XSUB(j)  (1280 + 64 * (j))
#define XB_XGEN(j)  (2304 + 64 * (j))
#define XB_TOP      3328
#define XB_TOPGEN   3392
#define XCD_BAR_WORDS 3456
#define XB_SPIN_CAP (1u << 24)

__device__ __forceinline__ unsigned xb_ld(unsigned* p)              { return __hip_atomic_load(p, __ATOMIC_RELAXED, __HIP_MEMORY_SCOPE_AGENT); }
__device__ __forceinline__ unsigned xb_add(unsigned* p, unsigned v) { return __hip_atomic_fetch_add(p, v, __ATOMIC_RELAXED, __HIP_MEMORY_SCOPE_AGENT); }
__device__ __forceinline__ unsigned xb_xcc_id() { return (unsigned)__builtin_amdgcn_s_getreg((3 << 11) | 20) & 0xFu; }
#define XB_SPIN(cond, bar) do { unsigned _sp = 0; while (cond) { __builtin_amdgcn_s_sleep(1); \
    if ((++_sp & 255u) == 0u) { if (xb_ld(&(bar)[XB_TMO])) break; if (_sp > XB_SPIN_CAP) { atomicAdd(&(bar)[XB_TMO], 1u); break; } } } } while (0)

struct XcdBarrier {
    unsigned* bar; unsigned x;
    volatile LAS unsigned* st;
};

__device__ __forceinline__ XcdBarrier xcd_barrier_post(unsigned* bar, volatile LAS unsigned* st) {
    XcdBarrier b; b.bar = bar; b.x = xb_xcc_id(); b.st = st;
    if (threadIdx.x == 0) (void)xb_add(&bar[XB_XCNT(b.x)], 1u);
    return b;
}
__device__ __forceinline__ void xcd_barrier_complete(unsigned* bar, unsigned x, unsigned& nloc, unsigned& nx) {
    const unsigned G = gridDim.x * gridDim.y * gridDim.z;
    unsigned sum, cnt, mine, sp = 0u;
    for (;;) {
        sum = 0u; cnt = 0u; mine = 0u;
#pragma unroll
        for (unsigned j = 0; j < 16; ++j) { const unsigned c = xb_ld(&bar[XB_XCNT(j)]); sum += c; cnt += (c > 0u) ? 1u : 0u; mine = (j == x) ? c : mine; }
        if (sum == G) break;
        __builtin_amdgcn_s_sleep(1);
        if ((++sp & 255u) == 0u) { if (xb_ld(&bar[XB_TMO])) break; if (sp > XB_SPIN_CAP) { atomicAdd(&bar[XB_TMO], 1u); break; } }
    }
    nloc = mine > 0u ? mine : 1u; nx = cnt > 0u ? cnt : 1u;
}

__device__ __forceinline__ void xcd_barrier(const XcdBarrier& b) {
    asm volatile("s_waitcnt vmcnt(0)" ::: "memory");
    __syncthreads();
    if (threadIdx.x == 0) {
        unsigned* bar = b.bar;
        __builtin_amdgcn_s_waitcnt(0);
        unsigned nloc = b.st[0], nx = b.st[1];
        if (nloc == 0u) { xcd_barrier_complete(bar, b.x, nloc, nx); b.st[0] = nloc; b.st[1] = nx; }
        const unsigned old = xb_add(&bar[XB_XSUB(b.x)], 1u);
        const unsigned gen = old / nloc;
        if (old + 1u == (gen + 1u) * nloc) {
            __builtin_amdgcn_fence(__ATOMIC_RELEASE, "agent");
            asm volatile("s_waitcnt vmcnt(0)" ::: "memory");
            const unsigned og = xb_add(&bar[XB_TOP], 1u);
            const unsigned tg = og / nx;
            if (og + 1u == (tg + 1u) * nx) xb_add(&bar[XB_TOPGEN], 1u);
            else XB_SPIN(xb_ld(&bar[XB_TOPGEN]) == tg, bar);
            __builtin_amdgcn_fence(__ATOMIC_ACQUIRE, "agent");
            xb_add(&bar[XB_XGEN(b.x)], 1u);
            asm volatile("s_waitcnt vmcnt(0)" ::: "memory");
        } else {
            XB_SPIN(xb_ld(&bar[XB_XGEN(b.x)]) == gen, bar);
            __builtin_amdgcn_fence(__ATOMIC_ACQUIRE, "agent");
            asm volatile("s_waitcnt vmcnt(0)" ::: "memory");
        }
    }
    __syncthreads();
}

constexpr int NWAVES = 8;
constexpr int BATCH = 2, SEQ = 16384, DM = 2048, T = BATCH * SEQ;
constexpr int GH = 4, GDK = 128, GDV = 256, GWK = 512, GWV = 1024, GRANK = 16;
constexpr int MH = 8, MDH = 128, MW = 1024, MBLK = 256, NBLK = SEQ / MBLK;
constexpr int NSRC = 11280;
constexpr int NPA = 5120, NPB = 6144;
constexpr int NP = 11520;
constexpr float NORM_EPS = 1e-6f;
constexpr int A_GQ = 0, A_GK = 512, A_GV = 1024, A_MQ = 2048, A_MK = 3072, A_MV = 4096;
constexpr int B_GS = 0, B_MS = 1024, B_GA = 2048, B_GB = 4096;

constexpr size_t MiB = 1u << 20;
constexpr size_t WS_CTL = 0, CTL_ZERO_BYTES = 1 * MiB;
constexpr size_t WS_KMEAN = 1 * MiB;
constexpr size_t WS_WIN = 2 * MiB;
constexpr size_t WS_WCAT = 47 * MiB;
constexpr size_t WS_WOUT = 55 * MiB;
constexpr size_t WS_GLR = 63 * MiB;
constexpr size_t WS_SEL = 65 * MiB;
constexpr size_t WS_XN = 70 * MiB;
constexpr size_t WS_ACAT = WS_XN;
constexpr size_t WS_PA = 198 * MiB;
constexpr size_t WS_MG = WS_PA;
constexpr size_t WS_PB = 518 * MiB;
constexpr size_t WS_DEC = 902 * MiB;
constexpr size_t WS_DG = 904 * MiB;
constexpr size_t WS_ULOC = 906 * MiB;
constexpr size_t WS_END = 938 * MiB;

constexpr int CW_BAR = 4096;

constexpr int RING_OFF = 0, RING_BYTES = 131072;
constexpr int LDSCTL_OFF = RING_BYTES, MISC_OFF = LDSCTL_OFF + 320;
constexpr int LDS_BYTES = 147456;

__device__ __forceinline__ float bflo(unsigned u) { return __builtin_bit_cast(float, u << 16); }
__device__ __forceinline__ float bfhi(unsigned u) { return __builtin_bit_cast(float, u & 0xffff0000u); }
__device__ __forceinline__ float bf2f(unsigned short u) { return __builtin_bit_cast(float, (unsigned)u << 16); }
__device__ __forceinline__ float sigmoidf_(float v) { return __builtin_amdgcn_rcpf(1.0f + __builtin_amdgcn_exp2f(-1.44269504089f * v)); }
__device__ __forceinline__ float wave_sum(float v) {
#pragma unroll
    for (int o = 1; o < 64; o <<= 1) v += __shfl_xor(v, o);
    return v;
}
__device__ __forceinline__ float wave_max(float v) {
#pragma unroll
    for (int o = 1; o < 64; o <<= 1) v = fmaxf(v, __shfl_xor(v, o));
    return v;
}

namespace pg8 {
struct EpiProj {
    static constexpr bool PERM = true, AFTER_DRAIN = false, MID_HOOK = false;
    bf16_t* PA; bf16_t* PB; float* GLR;
    __device__ __forceinline__ void operator()(const f32x4 (&acc)[2][2][4][2], const Unit& u, int wr, int wc, int fr, int fq) const {
        const int pn = u.pn, row0 = u.pm * BM + wr * 64 + fr;
        if (pn < 20) {
            const float sc = pn < 2 ? 0.08838834764831845f : 1.0f;
            const int col0 = pn * BM + wc * 32 + 8 * fq;
#pragma unroll
            for (int ai = 0; ai < 2; ++ai)
#pragma unroll
                for (int m = 0; m < 4; ++m) { bf16_t* rowp = PA + (size_t)(row0 + ai * HALF + m * 16) * NPA + col0;
#pragma unroll
                    for (int bj = 0; bj < 2; ++bj) { const f32x4 v0 = acc[ai][bj][m][0] * sc, v1 = acc[ai][bj][m][1] * sc;
                        u32x4 w; w.x = cvt_pk_bf16(v0[0], v0[1]); w.y = cvt_pk_bf16(v0[2], v0[3]); w.z = cvt_pk_bf16(v1[0], v1[1]); w.w = cvt_pk_bf16(v1[2], v1[3]);
                        *(u32x4*)(rowp + bj * HALF) = w; } }
        } else if (pn < 44) {
            const bool is_silu = pn < 28;
            const int col0 = (pn - 20) * BM + wc * 32 + 8 * fq;
#pragma unroll
            for (int ai = 0; ai < 2; ++ai)
#pragma unroll
                for (int m = 0; m < 4; ++m) { bf16_t* rowp = PB + (size_t)(row0 + ai * HALF + m * 16) * NPB + col0;
#pragma unroll
                    for (int bj = 0; bj < 2; ++bj) { float v[8];
#pragma unroll
                        for (int i = 0; i < 4; ++i) { v[i] = acc[ai][bj][m][0][i]; v[4 + i] = acc[ai][bj][m][1][i]; }
#pragma unroll
                        for (int i = 0; i < 8; ++i) { const float s = sigmoidf_(v[i]); v[i] = is_silu ? v[i] * s : s; }
                        u32x4 w; w.x = cvt_pk_bf16(v[0], v[1]); w.y = cvt_pk_bf16(v[2], v[3]); w.z = cvt_pk_bf16(v[4], v[5]); w.w = cvt_pk_bf16(v[6], v[7]);
                        *(u32x4*)(rowp + bj * HALF) = w; } }
        } else {
            if (wc == 0 && fq < 2) {
#pragma unroll
                for (int ai = 0; ai < 2; ++ai)
#pragma unroll
                    for (int m = 0; m < 4; ++m) { float* rowp = GLR + (size_t)(row0 + ai * HALF + m * 16) * 16 + 8 * fq;
                        *(f32x4*)(rowp) = acc[ai][0][m][0]; *(f32x4*)(rowp + 4) = acc[ai][0][m][1]; }
            }
        }
    }
};
struct EpiMerge {
    static constexpr bool PERM = true, AFTER_DRAIN = false, MID_HOOK = true;
    const bf16_t* PB; bf16_t* MG;
    __device__ __forceinline__ void mid(f32x4 (&acc)[2][2][4][2], const Unit& u, int wr, int wc, int fr, int fq) const {
        int opq; asm volatile("v_mov_b32 %0, 0" : "=v"(opq));
        const int row0 = u.pm * BM + wr * 64 + fr + opq, col0 = u.pn * BM + wc * 32 + 8 * fq;
#pragma unroll
        for (int ai = 0; ai < 2; ++ai)
#pragma unroll
            for (int m = 0; m < 4; ++m) { const bf16_t* rowp = PB + (size_t)(row0 + ai * HALF + m * 16) * NPB + col0;
#pragma unroll
                for (int bj = 0; bj < 2; ++bj) {
                    const u32x4 a = *(const u32x4*)(rowp + B_GA + bj * HALF), b = *(const u32x4*)(rowp + B_GB + bj * HALF);
                    f32x4 r0, r1;
                    r0[0] = bflo(a.x) * __builtin_amdgcn_rcpf(bflo(b.x)); r0[1] = bfhi(a.x) * __builtin_amdgcn_rcpf(bfhi(b.x));
                    r0[2] = bflo(a.y) * __builtin_amdgcn_rcpf(bflo(b.y)); r0[3] = bfhi(a.y) * __builtin_amdgcn_rcpf(bfhi(b.y));
                    r1[0] = bflo(a.z) * __builtin_amdgcn_rcpf(bflo(b.z)); r1[1] = bfhi(a.z) * __builtin_amdgcn_rcpf(bfhi(b.z));
                    r1[2] = bflo(a.w) * __builtin_amdgcn_rcpf(bflo(b.w)); r1[3] = bfhi(a.w) * __builtin_amdgcn_rcpf(bfhi(b.w));
                    acc[ai][bj][m][0] = acc[ai][bj][m][0] * r0; acc[ai][bj][m][1] = acc[ai][bj][m][1] * r1; }
                __builtin_amdgcn_sched_barrier(0); }
    }
    __device__ __forceinline__ void operator()(const f32x4 (&acc)[2][2][4][2], const Unit& u, int wr, int wc, int fr, int fq) const {
        const int row0 = u.pm * BM + wr * 64 + fr, col0 = u.pn * BM + wc * 32 + 8 * fq;
#pragma unroll
        for (int ai = 0; ai < 2; ++ai)
#pragma unroll
            for (int m = 0; m < 4; ++m) { const size_t row = (size_t)(row0 + ai * HALF + m * 16); const bf16_t* gp = PB + row * NPB + B_GB + col0; bf16_t* op = MG + row * DM + col0;
#pragma unroll
                for (int bj = 0; bj < 2; ++bj) { const u32x4 b = *(const u32x4*)(gp + bj * HALF);
                    const f32x4 v0 = acc[ai][bj][m][0], v1 = acc[ai][bj][m][1];
                    u32x4 w; w.x = cvt_pk_bf16(v0[0] * bflo(b.x), v0[1] * bfhi(b.x)); w.y = cvt_pk_bf16(v0[2] * bflo(b.y), v0[3] * bfhi(b.y));
                    w.z = cvt_pk_bf16(v1[0] * bflo(b.z), v1[1] * bfhi(b.z)); w.w = cvt_pk_bf16(v1[2] * bflo(b.w), v1[3] * bfhi(b.w));
                    *(u32x4*)(op + bj * HALF) = w; } }
    }
};
struct EpiOut {
    static constexpr bool PERM = true, AFTER_DRAIN = false, MID_HOOK = false;
    const float* X; float* O;
    __device__ __forceinline__ void operator()(const f32x4 (&acc)[2][2][4][2], const Unit& u, int wr, int wc, int fr, int fq) const {
        const int row0 = u.pm * BM + wr * 64 + fr, col0 = u.pn * BM + wc * 32 + 8 * fq;
#pragma unroll
        for (int ai = 0; ai < 2; ++ai)
#pragma unroll
            for (int m = 0; m < 4; ++m) { const size_t off = (size_t)(row0 + ai * HALF + m * 16) * DM + col0;
#pragma unroll
                for (int bj = 0; bj < 2; ++bj) { const float* xp = X + off + bj * HALF; float* op = O + off + bj * HALF;
                    const f32x4 x0 = *(const f32x4*)xp, x1 = *(const f32x4*)(xp + 4);
                    *(f32x4*)op = x0 + acc[ai][bj][m][0]; *(f32x4*)(op + 4) = x1 + acc[ai][bj][m][1]; } }
    }
};
}

struct Frame {
    LAS unsigned char* lds;
    int tid, lane, wave, vcu, G;
    const float *x, *norm_g, *w_in, *w_gate, *b_gate, *gla_g, *qn_g, *kn_g, *w_bg, *w_bm, *w_out;
    float* out;
    bf16 *WIN, *WCAT, *WOUT, *XN, *ACAT, *PA, *PB, *MG;
    float *GLR, *KMEAN, *OG;
    int* SEL;
};

__device__ __forceinline__ int win_src_col(int d) {
    if (d < 2048) return d;
    if (d < 5120) return d - 2048 + 3088;
    if (d < 6144) return d - 5120 + 2064;
    if (d < 7168) return d - 6144 + 6160;
    if (d < 11264) return d - 7168 + 7184;
    if (d < 11280) return d - 11264 + 2048;
    return -1;
}
template <bool MAPPED>
__device__ __forceinline__ void transpose_item(const float* W, int Nsrc, bf16* WT, int ldk, int koff, int k0, int n0, LAS float* scr, int lane) {
    const int nn = n0 + (lane & 31);
    const int sc = MAPPED ? win_src_col(nn) : nn;
#pragma unroll 8
    for (int i = 0; i < 32; ++i) { const int kk = 2 * i + (lane >> 5); scr[kk * 33 + (lane & 31)] = sc >= 0 ? W[(size_t)(k0 + kk) * Nsrc + sc] : 0.f; }
    LDS_WAIT(); asm volatile("" ::: "memory");
    const int c = lane & 7;
#pragma unroll
    for (int j = 0; j < 4; ++j) { const int n = (lane >> 3) + 8 * j; const LAS float* s = scr + (8 * c) * 33 + n;
        v4u o; o.x = pk2(s[0 * 33], s[1 * 33]); o.y = pk2(s[2 * 33], s[3 * 33]); o.z = pk2(s[4 * 33], s[5 * 33]); o.w = pk2(s[6 * 33], s[7 * 33]);
        *(GAS v4u*)(WT + (size_t)(n0 + n) * ldk + koff + k0 + 8 * c) = o; }
    LDS_WAIT(); asm volatile("" ::: "memory");
}
__device__ __forceinline__ void p0_prologue(Frame& F) {
    LAS float* scr = (LAS float*)(F.lds + RING_OFF + F.wave * 16384);
    const int gw = F.vcu * NWAVES + F.wave, NGW = F.G * NWAVES;
    constexpr int NB_IN = 11296 / 32, I_IN = (DM / 64) * NB_IN;
    constexpr int I_BG = (1024 / 64) * (DM / 32), I_OUT = (DM / 64) * (DM / 32);
    constexpr int NITEMS = I_IN + 2 * I_BG + I_OUT;
    for (int it = gw; it < NITEMS; it += NGW) {
        int r = it;
        if (r < I_IN) { const int kb = r / NB_IN, nb = r % NB_IN; transpose_item<true>(F.w_in, NSRC, F.WIN, DM, 0, 64 * kb, 32 * nb, scr, F.lane); continue; } r -= I_IN;
        if (r < I_BG) { const int kb = r / (DM / 32), nb = r % (DM / 32); transpose_item<false>(F.w_bg, DM, F.WCAT, 2048, 0, 64 * kb, 32 * nb, scr, F.lane); continue; } r -= I_BG;
        if (r < I_BG) { const int kb = r / (DM / 32), nb = r % (DM / 32); transpose_item<false>(F.w_bm, DM, F.WCAT, 2048, 1024, 64 * kb, 32 * nb, scr, F.lane); continue; } r -= I_BG;
        { const int kb = r / (DM / 32), nb = r % (DM / 32); transpose_item<false>(F.w_out, DM, F.WOUT, DM, 0, 64 * kb, 32 * nb, scr, F.lane); }
    }
    f32x4 g[8];
#pragma unroll
    for (int j = 0; j < 8; ++j) g[j] = ((const GAS f32x4*)F.norm_g)[64 * j + F.lane];
    for (int m = gw; m < T; m += NGW) {
        const GAS f32x4* xr = (const GAS f32x4*)(F.x + (size_t)m * DM) + F.lane;
        f32x4 v[8]; float s = 0.f;
#pragma unroll
        for (int j = 0; j < 8; ++j) { v[j] = xr[64 * j]; s += (v[j].x * v[j].x + v[j].y * v[j].y) + (v[j].z * v[j].z + v[j].w * v[j].w); }
        const float r = 1.0f / sqrtf(wave_sum(s) * (1.0f / DM) + NORM_EPS);
        GAS unsigned long long* o8 = (GAS unsigned long long*)(F.XN + (size_t)m * DM) + F.lane;
#pragma unroll
        for (int j = 0; j < 8; ++j) { const f32x4 y = v[j] * r * g[j]; o8[64 * j] = (unsigned long long)pk2(y.x, y.y) | ((unsigned long long)pk2(y.z, y.w) << 32); }
    }
}

__device__ __forceinline__ void m0_qknorm(Frame& F) {
    LAS float* red = (LAS float*)(F.lds);
    const int rg = F.tid >> 4, l16 = F.tid & 15;
    for (int item = F.vcu; item < BATCH * NBLK * MH; item += F.G) {
        const int h = item % MH, blk = (item / MH) % NBLK, b = item / (MH * NBLK);
        float gq[8], gk[8], cs[8];
#pragma unroll
        for (int e = 0; e < 8; ++e) { gq[e] = F.qn_g[l16 * 8 + e]; gk[e] = F.kn_g[l16 * 8 + e]; cs[e] = 0.f; }
        for (int it = 0; it < 8; ++it) {
            const size_t row = (size_t)b * SEQ + blk * MBLK + it * 32 + rg;
#pragma unroll
            for (int w = 0; w < 2; ++w) {
                bf16* p = F.PA + row * NPA + (w ? A_MK : A_MQ) + h * MDH + l16 * 8;
                const v4u raw = *(const GAS v4u*)p; float v[8];
                v[0] = bflo(raw.x); v[1] = bfhi(raw.x); v[2] = bflo(raw.y); v[3] = bfhi(raw.y); v[4] = bflo(raw.z); v[5] = bfhi(raw.z); v[6] = bflo(raw.w); v[7] = bfhi(raw.w);
                float ss = 0.f;
#pragma unroll
                for (int e = 0; e < 8; ++e) ss += v[e] * v[e];
                ss += __shfl_xor(ss, 1); ss += __shfl_xor(ss, 2); ss += __shfl_xor(ss, 4); ss += __shfl_xor(ss, 8);
                const float r = 1.0f / sqrtf(ss * (1.0f / MDH) + NORM_EPS);
#pragma unroll
                for (int e = 0; e < 8; ++e) { v[e] = v[e] * r * (w ? gk[e] : gq[e]); if (w) cs[e] += v[e]; }
                v4u o; o.x = pk2(v[0], v[1]); o.y = pk2(v[2], v[3]); o.z = pk2(v[4], v[5]); o.w = pk2(v[6], v[7]);
                *(GAS v4u*)p = o;
            }
        }
#pragma unroll
        for (int e = 0; e < 8; ++e) red[rg * 128 + l16 * 8 + e] = cs[e];
        __syncthreads();
        if (F.tid < 128) { float s = 0.f;
#pragma unroll 8
            for (int r = 0; r < 32; ++r) s += red[r * 128 + F.tid];
            F.KMEAN[((size_t)(b * MH + h) * NBLK + blk) * MDH + F.tid] = s * (1.0f / MBLK); }
        __syncthreads();
    }
}

__device__ __forceinline__ void m1_select(Frame& F) {
    LAS float* km = (LAS float*)(F.lds);
    for (int item = F.vcu; item < BATCH * MH * (SEQ / 512); item += F.G) {
        const int qc = item % (SEQ / 512), h = (item / (SEQ / 512)) % MH, b = item / ((SEQ / 512) * MH);
        __syncthreads();
        for (int i = F.tid; i < NBLK * MDH; i += NWAVES * 64) { const int j = i / MDH, d = i % MDH; km[d * NBLK + j] = F.KMEAN[(size_t)(b * MH + h) * NBLK * MDH + i]; }
        __syncthreads();
        const int t = qc * 512 + F.tid, qb = t / MBLK;
        const bf16* qp = F.PA + ((size_t)b * SEQ + t) * NPA + A_MQ + h * MDH;
        float acc[NBLK];
#pragma unroll
        for (int j = 0; j < NBLK; ++j) acc[j] = 0.f;
        for (int c = 0; c < 16; ++c) {
            const v4u raw = *(const GAS v4u*)(qp + c * 8); float q[8];
            q[0] = bflo(raw.x); q[1] = bfhi(raw.x); q[2] = bflo(raw.y); q[3] = bfhi(raw.y); q[4] = bflo(raw.z); q[5] = bfhi(raw.z); q[6] = bflo(raw.w); q[7] = bfhi(raw.w);
#pragma unroll
            for (int e = 0; e < 8; ++e) { const LAS f32x4* kr = (const LAS f32x4*)(km + (c * 8 + e) * NBLK);
#pragma unroll
                for (int j4 = 0; j4 < NBLK / 4; ++j4) { const f32x4 kv = kr[j4];
                    acc[4 * j4 + 0] = fmaf(q[e], kv.x, acc[4 * j4 + 0]); acc[4 * j4 + 1] = fmaf(q[e], kv.y, acc[4 * j4 + 1]);
                    acc[4 * j4 + 2] = fmaf(q[e], kv.z, acc[4 * j4 + 2]); acc[4 * j4 + 3] = fmaf(q[e], kv.w, acc[4 * j4 + 3]); } }
        }
        float b0 = -3.0e38f, b1 = -3.0e38f, b2 = -3.0e38f; int i0 = -1, i1 = -1, i2 = -1;
#pragma unroll
        for (int j = 0; j < NBLK; ++j) {
            const float v = (j < qb) ? acc[j] : -3.0e38f;
            const bool c0 = v > b0, c1 = v > b1, c2 = v > b2;
            b2 = c1 ? b1 : (c2 ? v : b2); i2 = c1 ? i1 : (c2 ? j : i2);
            b1 = c0 ? b0 : (c1 ? v : b1); i1 = c0 ? i0 : (c1 ? j : i1);
            b0 = c0 ? v : b0; i0 = c0 ? j : i0;
        }
        int sel[3] = {i0, i1, i2};
        int4 o; o.x = sel[0]; o.y = sel[1]; o.z = sel[2]; o.w = -1;
        *(int4*)(F.SEL + (((size_t)(b * MH + h) * SEQ + t) * 4)) = o;
    }
}

__device__ __forceinline__ void m2_attn_naive(Frame& F) {
    LAS float* P = (LAS float*)(F.lds) + F.wave * 1024;
    const int gw = F.vcu * NWAVES + F.wave, NGW = F.G * NWAVES;
    for (int item = gw; item < BATCH * MH * SEQ; item += NGW) {
        const int t = item % SEQ, h = (item / SEQ) % MH, b = item / (SEQ * MH);
        const int own = t / MBLK;
        const int4 s4 = *(const int4*)(F.SEL + (((size_t)(b * MH + h) * SEQ + t) * 4));
        unsigned blks = 0u; int nb = 0;
        if (s4.x >= 0) { blks |= (unsigned)s4.x << (8 * nb); ++nb; } if (s4.y >= 0) { blks |= (unsigned)s4.y << (8 * nb); ++nb; } if (s4.z >= 0) { blks |= (unsigned)s4.z << (8 * nb); ++nb; }
        blks |= (unsigned)own << (8 * nb); ++nb;
        const float slope = __builtin_amdgcn_exp2f(-(float)(h + 1));
        const bf16* qp = F.PA + ((size_t)b * SEQ + t) * NPA + A_MQ + h * MDH;
        v4u q[16];
#pragma unroll
        for (int c = 0; c < 16; ++c) q[c] = *(const GAS v4u*)(qp + c * 8);
        float mx = -3.0e38f;
        for (int bi = 0; bi < nb; ++bi) {
            const int blk = (int)((blks >> (8 * bi)) & 0xffu);
            for (int kc = 0; kc < 4; ++kc) {
                const int pos = blk * MBLK + kc * 64 + F.lane;
                const bf16* kp = F.PA + ((size_t)b * SEQ + pos) * NPA + A_MK + h * MDH;
                float s = 0.f;
#pragma unroll
                for (int c = 0; c < 16; ++c) { const v4u kv = *(const GAS v4u*)(kp + c * 8);
                    s += bflo(kv.x) * bflo(q[c].x) + bfhi(kv.x) * bfhi(q[c].x) + bflo(kv.y) * bflo(q[c].y) + bfhi(kv.y) * bfhi(q[c].y)
                       + bflo(kv.z) * bflo(q[c].z) + bfhi(kv.z) * bfhi(q[c].z) + bflo(kv.w) * bflo(q[c].w) + bfhi(kv.w) * bfhi(q[c].w); }
                s = s * 0.08838834764831845f - slope * (float)(t - pos);
                if (pos > t) s = -1.0e30f;
                P[bi * 256 + kc * 64 + F.lane] = s; mx = fmaxf(mx, s);
            }
        }
        mx = wave_max(mx);
        float l = 0.f;
        for (int i = F.lane; i < nb * 256; i += 64) { const float p = __builtin_amdgcn_exp2f((P[i] - mx) * 1.44269504089f); P[i] = p; l += p; }
        l = wave_sum(l);
        LDS_WAIT(); asm volatile("" ::: "memory");
        float o0 = 0.f, o1 = 0.f;
        for (int bi = 0; bi < nb; ++bi) {
            const bf16* vp = F.PA + ((size_t)b * SEQ + (int)((blks >> (8 * bi)) & 0xffu) * MBLK) * NPA + A_MV + h * MDH + 2 * F.lane;
#pragma unroll 8
            for (int k = 0; k < 256; ++k) { const float p = P[bi * 256 + k]; const unsigned vv = *(const GAS unsigned*)(vp + (size_t)k * NPA); o0 = fmaf(p, bflo(vv), o0); o1 = fmaf(p, bfhi(vv), o1); }
        }
        const float inv = 1.0f / l;
        const unsigned gs = *(const GAS unsigned*)(F.PB + ((size_t)b * SEQ + t) * NPB + B_MS + h * MDH + 2 * F.lane);
        *(GAS unsigned*)(F.ACAT + ((size_t)b * SEQ + t) * 2048 + 1024 + h * MDH + 2 * F.lane) = pk2(o0 * inv * bflo(gs), o1 * inv * bfhi(gs));
        LDS_WAIT(); asm volatile("" ::: "memory");
    }
}

__device__ __forceinline__ void gla_naive(Frame& F) {
    LAS float* Wg = (LAS float*)(F.lds);
    LAS float* bg = Wg + 16 * 128;
    LAS float* glr = bg + 128;
    LAS float* aa = glr + 64 * 16;
    LAS float* qq = aa + 64 * 128;
    LAS float* kk = qq + 64 * 128;
    LAS float* vv = kk + 64 * 128;
    for (int item = F.vcu; item < BATCH * GH * (GDV / 8); item += F.G) {
        const int dvs = item % (GDV / 8), h = (item / (GDV / 8)) % GH, b = item / ((GDV / 8) * GH);
        __syncthreads();
        for (int i = F.tid; i < 16 * 128; i += 512) Wg[i] = F.w_gate[(size_t)(i / 128) * GWK + h * GDK + (i % 128)];
        if (F.tid < 128) bg[F.tid] = F.b_gate[h * GDK + F.tid];
        float S0 = 0.f, S1 = 0.f;
        const int dv = dvs * 8 + F.wave;
        for (int c0 = 0; c0 < SEQ; c0 += 64) {
            __syncthreads();
            const size_t rowb = (size_t)b * SEQ + c0;
            for (int i = F.tid; i < 64 * 16; i += 512) glr[i] = F.GLR[rowb * 16 + i];
            for (int i = F.tid; i < 64 * 128; i += 512) { const int r = i >> 7, d = i & 127; const bf16* p = F.PA + (rowb + r) * NPA + h * GDK + d; qq[i] = bf2f(p[A_GQ]); kk[i] = bf2f(p[A_GK]); }
            { const int r = F.tid >> 3, j = F.tid & 7; vv[F.tid] = bf2f(F.PA[(rowb + r) * NPA + A_GV + h * GDV + dvs * 8 + j]); }
            __syncthreads();
            for (int i = F.tid; i < 64 * 128; i += 512) { const int r = i >> 7, d = i & 127; float z = bg[d];
#pragma unroll
                for (int j = 0; j < 16; ++j) z = fmaf(glr[r * 16 + j], Wg[j * 128 + d], z);
                const float ls = fminf(z, 0.f) - log1pf(expf(-fabsf(z)));
                aa[i] = expf(ls * (1.0f / 16.0f)); }
            __syncthreads();
            for (int r = 0; r < 64; ++r) {
                const float v = vv[r * 8 + F.wave];
                S0 = aa[r * 128 + F.lane] * S0 + kk[r * 128 + F.lane] * v;
                S1 = aa[r * 128 + 64 + F.lane] * S1 + kk[r * 128 + 64 + F.lane] * v;
                const float o = wave_sum(qq[r * 128 + F.lane] * S0 + qq[r * 128 + 64 + F.lane] * S1);
                if (F.lane == 0) F.OG[(rowb + r) * GWV + h * GDV + dv] = o;
            }
        }
    }
}
__device__ __forceinline__ void gla_post(Frame& F) {
    const int gw = F.vcu * NWAVES + F.wave, NGW = F.G * NWAVES;
    const f32x4 g = ((const GAS f32x4*)F.gla_g)[F.lane];
    for (int item = gw; item < T * GH; item += NGW) {
        const int h = item % GH; const size_t row = item / GH;
        const f32x4 o = ((const GAS f32x4*)(F.OG + row * GWV + h * GDV))[F.lane];
        const float ss = wave_sum((o.x * o.x + o.y * o.y) + (o.z * o.z + o.w * o.w));
        const float r = 1.0f / sqrtf(ss * (1.0f / GDV) + NORM_EPS);
        const unsigned long long gs = *(const GAS unsigned long long*)(F.PB + row * NPB + B_GS + h * GDV + 4 * F.lane);
        const unsigned lo = (unsigned)gs, hi = (unsigned)(gs >> 32);
        const unsigned long long w = (unsigned long long)pk2(o.x * r * g.x * bflo(lo), o.y * r * g.y * bfhi(lo)) | ((unsigned long long)pk2(o.z * r * g.z * bflo(hi), o.w * r * g.w * bfhi(hi)) << 32);
        *(GAS unsigned long long*)(F.ACAT + row * 2048 + h * GDV + 4 * F.lane) = w;
    }
}


typedef float f32x16 __attribute__((ext_vector_type(16)));
typedef float f32x2 __attribute__((ext_vector_type(2)));
typedef short s16x4 __attribute__((ext_vector_type(4)));
typedef __bf16 bf16x2_t __attribute__((ext_vector_type(2)));
#define MFMA32(a, b, c) __builtin_amdgcn_mfma_f32_32x32x16_bf16((a), (b), (c), 0, 0, 0)
__device__ __forceinline__ unsigned pkbf(float lo, float hi) { f32x2 v; v.x = lo; v.y = hi; return __builtin_bit_cast(unsigned, __builtin_convertvector(v, bf16x2_t)); }
__device__ __forceinline__ unsigned off_b(unsigned row, unsigned ch) { return 256u * row + 16u * (ch ^ (((row & 3u) << 2) | ((row >> 2) & 3u))); }
__device__ __forceinline__ int crow(int reg, int h) { return (reg & 3) + 8 * (reg >> 2) + 4 * h; }
__device__ __forceinline__ bf16x8 tr_frag(LAS unsigned char* tile, int lane, int rowbase, int c) {
    const unsigned h = lane >> 5, blk = (lane >> 4) & 1, q = (lane & 15) >> 2, p = lane & 3;
    const unsigned a0 = off_b(rowbase + 8 * h + q, 4 * c + 2 * blk + (p >> 1)) + 8 * (p & 1);
    const unsigned a1 = off_b(rowbase + 8 * h + 4 + q, 4 * c + 2 * blk + (p >> 1)) + 8 * (p & 1);
    const s16x4 lo = __builtin_amdgcn_ds_read_tr16_b64_v4i16((LAS s16x4*)(tile + a0));
    const s16x4 hi = __builtin_amdgcn_ds_read_tr16_b64_v4i16((LAS s16x4*)(tile + a1));
    return __builtin_shufflevector(lo, hi, 0, 1, 2, 3, 4, 5, 6, 7);
}
__device__ __forceinline__ bf16x8 row_frag(LAS unsigned char* tile, int row, int s, int h) { return *(const LAS bf16x8*)(tile + off_b(row, 2 * s + h)); }
__device__ __forceinline__ bf16x8 perm_frag(LAS unsigned char* tile, int row, int kb, int s, int h) {
    const s16x4 lo = *(const LAS s16x4*)(tile + off_b(row, 4 * kb + 2 * s) + 8 * h);
    const s16x4 hi = *(const LAS s16x4*)(tile + off_b(row, 4 * kb + 2 * s + 1) + 8 * h);
    return __builtin_shufflevector(lo, hi, 0, 1, 2, 3, 4, 5, 6, 7);
}
__device__ __forceinline__ bf16x8 pack_acc(const f32x16& x, int s) {
    v4u p; p.x = pkbf(x[8 * s], x[8 * s + 1]); p.y = pkbf(x[8 * s + 2], x[8 * s + 3]); p.z = pkbf(x[8 * s + 4], x[8 * s + 5]); p.w = pkbf(x[8 * s + 6], x[8 * s + 7]);
    return __builtin_bit_cast(bf16x8, p);
}
constexpr int G_NC = 8, G_NG = (SEQ / 64) / G_NC;

__device__ __forceinline__ void gla_g1(Frame& F, float* DEC, float* DG, float* ULOC) {
    LAS unsigned char* KT = F.lds;
    LAS unsigned char* VT = F.lds + 16384;
    LAS float* glr = (LAS float*)(F.lds + 49152);
    LAS float* Wg = (LAS float*)(F.lds + 53248);
    LAS float* bg = (LAS float*)(F.lds + 61440);
    LAS float* tot = (LAS float*)(F.lds + 62464);
    LAS float* dvec = (LAS float*)(F.lds + 64512);
    const int w = F.wave;
    for (int item = F.vcu; item < BATCH * GH * G_NG; item += F.G) {
        const int g = item % G_NG, hd = (item / G_NG) % GH, b = item / (G_NG * GH);
        const int d = F.tid & 127, qr = F.tid >> 7;
        __syncthreads();
        for (int i = F.tid; i < 16 * 128; i += 512) Wg[i] = F.w_gate[(size_t)(i >> 7) * GWK + hd * GDK + (i & 127)];
        if (F.tid < 128) bg[F.tid] = F.b_gate[hd * GDK + F.tid];
        __syncthreads();
        float wg[16];
#pragma unroll
        for (int j = 0; j < 16; ++j) wg[j] = Wg[j * 128 + d];
        const float bias = bg[d];
        float Dg = 1.0f;
        f32x16 U[4];
#pragma unroll
        for (int mt = 0; mt < 4; ++mt)
#pragma unroll
            for (int i = 0; i < 16; ++i) U[mt][i] = 0.f;
        for (int c = 0; c < G_NC; ++c) {
            const int cc = g * G_NC + c; const size_t rowb = (size_t)b * SEQ + (size_t)cc * 64;
            int lane = F.lane; asm volatile("" : "+v"(lane));
            const int h2 = lane >> 5, r = lane & 31;
            int tido = F.tid; asm volatile("" : "+v"(tido));
            const int d = tido & 127, qr = tido >> 7;
            __syncthreads();
            for (int i = F.tid; i < 64 * 16; i += 512) glr[i] = F.GLR[rowb * 16 + i];
            for (int i = F.tid; i < 2048; i += 512) { const int row = i >> 5, c32 = i & 31;
                const v4u val = *(const GAS v4u*)(F.PA + (rowb + row) * NPA + A_GV + hd * GDV + c32 * 8);
                *(LAS v4u*)(VT + (c32 >> 4) * 16384 + off_b(row, c32 & 15)) = val; }
            __syncthreads();
            float loc[16]; float run = 0.f;
#pragma unroll
            for (int i = 0; i < 16; ++i) { const int row = 16 * qr + i; float z = bias;
#pragma unroll
                for (int j = 0; j < 16; ++j) z = fmaf(glr[row * 16 + j], wg[j], z);
                const float sp = __builtin_amdgcn_logf(1.0f + __builtin_amdgcn_exp2f(-fabsf(z) * 1.44269504089f)) * 0.69314718056f;
                run += (fminf(z, 0.f) - sp) * (1.0f / 16.0f); loc[i] = run; }
            tot[qr * 128 + d] = run;
            __syncthreads();
            float off = 0.f, total = 0.f;
#pragma unroll
            for (int q2 = 0; q2 < 4; ++q2) { const float tq = tot[q2 * 128 + d]; total += tq; off += (q2 < qr) ? tq : 0.f; }
            if (qr == 0) { const float dd = __builtin_amdgcn_exp2f(total * 1.44269504089f); dvec[d] = dd; DEC[((size_t)(b * GH + hd) * (SEQ / 64) + cc) * GDK + d] = dd; Dg *= dd; }
#pragma unroll
            for (int i = 0; i < 16; ++i) { const int row = 16 * qr + i; const float bb = loc[i] + off;
                bf16* p = F.PA + (rowb + row) * NPA + hd * GDK + d;
                const float eb = __builtin_amdgcn_exp2f(bb * 1.44269504089f), ebi = __builtin_amdgcn_exp2f(-bb * 1.44269504089f);
                const float qn = bf2f(p[A_GQ]) * eb, kn = bf2f(p[A_GK]) * ebi;
                const unsigned short kb16 = (unsigned short)f2bf(kn);
                p[A_GQ] = (unsigned short)f2bf(qn); p[A_GK] = kb16;
                *(LAS unsigned short*)(KT + off_b(row, d >> 3) + (d & 7) * 2) = kb16; }
            __syncthreads();
#pragma unroll
            for (int ks = 0; ks < 4; ++ks) { const bf16x8 Bf = tr_frag(VT + (w >> 2) * 16384, lane, 16 * ks, w & 3);
#pragma unroll
                for (int mt = 0; mt < 4; ++mt) { const bf16x8 Af = tr_frag(KT, lane, 16 * ks, mt); U[mt] = MFMA32(Af, Bf, U[mt]); } }
#pragma unroll
            for (int mt = 0; mt < 4; ++mt)
#pragma unroll
                for (int i = 0; i < 16; ++i) U[mt][i] *= dvec[32 * mt + crow(i, h2)];
        }
        float* up = ULOC + (size_t)((b * GH + hd) * G_NG + g) * GDK * GDV;
        { const int h2 = F.lane >> 5, r = F.lane & 31;
#pragma unroll
        for (int mt = 0; mt < 4; ++mt)
#pragma unroll
            for (int i = 0; i < 16; ++i) up[(size_t)(32 * mt + crow(i, h2)) * GDV + 32 * w + r] = U[mt][i]; }
        if (qr == 0) DG[((size_t)(b * GH + hd) * G_NG + g) * GDK + d] = Dg;
    }
}
__device__ __forceinline__ void gla_g2(Frame& F, const float* DG, float* ULOC) {
    const int gt = F.vcu * (NWAVES * 64) + F.tid, NT = F.G * NWAVES * 64;
    for (int e = gt; e < BATCH * GH * GDK * GDV; e += NT) {
        const int bh = e / (GDK * GDV), rem = e % (GDK * GDV), dk = rem / GDV;
        float S = 0.f;
#pragma unroll 8
        for (int g = 0; g < G_NG; ++g) { const size_t idx = (size_t)(bh * G_NG + g) * GDK * GDV + rem; const float u = ULOC[idx]; ULOC[idx] = S; S = fmaf(DG[(size_t)(bh * G_NG + g) * GDK + dk], S, u); }
    }
}
__device__ __forceinline__ void gla_g3(Frame& F, const float* DEC, const float* SST) {
    LAS unsigned char* QT = F.lds;
    LAS unsigned char* KT = F.lds + 16384;
    LAS unsigned char* VT = F.lds + 32768;
    LAS unsigned char* AT = F.lds + 65536;
    LAS float* dvec = (LAS float*)(F.lds + 75776);
    LAS float* red = (LAS float*)(F.lds + 76288);
    const int w = F.wave;
    for (int item = F.vcu; item < BATCH * GH * G_NG; item += F.G) {
        const int g = item % G_NG, hd = (item / G_NG) % GH, b = item / (G_NG * GH);
        f32x16 S[4];
        { const int h2 = F.lane >> 5, r = F.lane & 31; const float* sp = SST + (size_t)((b * GH + hd) * G_NG + g) * GDK * GDV;
#pragma unroll
          for (int mt = 0; mt < 4; ++mt)
#pragma unroll
              for (int i = 0; i < 16; ++i) S[mt][i] = sp[(size_t)(32 * mt + crow(i, h2)) * GDV + 32 * w + r]; }
        for (int c = 0; c < G_NC; ++c) {
            const int cc = g * G_NC + c; const size_t rowb = (size_t)b * SEQ + (size_t)cc * 64;
            int lane = F.lane; asm volatile("" : "+v"(lane));
            const int h2 = lane >> 5, r = lane & 31;
            __syncthreads();
            for (int i = F.tid; i < 1024; i += 512) { const int row = i >> 4, ch = i & 15; const bf16* p = F.PA + (rowb + row) * NPA + hd * GDK + ch * 8;
                *(LAS v4u*)(QT + off_b(row, ch)) = *(const GAS v4u*)(p + A_GQ); *(LAS v4u*)(KT + off_b(row, ch)) = *(const GAS v4u*)(p + A_GK); }
            for (int i = F.tid; i < 2048; i += 512) { const int row = i >> 5, c32 = i & 31;
                *(LAS v4u*)(VT + (c32 >> 4) * 16384 + off_b(row, c32 & 15)) = *(const GAS v4u*)(F.PA + (rowb + row) * NPA + A_GV + hd * GDV + c32 * 8); }
            if (F.tid < 128) dvec[F.tid] = DEC[((size_t)(b * GH + hd) * (SEQ / 64) + cc) * GDK + F.tid];
            __syncthreads();
            if (w < 3) {
                const int tj = w >> 1, ti = (w + 1) >> 1;
                f32x16 a;
#pragma unroll
                for (int i = 0; i < 16; ++i) a[i] = 0.f;
#pragma unroll
                for (int s = 0; s < 8; ++s) a = MFMA32(row_frag(KT, 32 * tj + r, s, h2), row_frag(QT, 32 * ti + r, s, h2), a);
                const int ii = 32 * ti + r;
#pragma unroll
                for (int g4 = 0; g4 < 4; ++g4) { const int j0 = 32 * tj + 8 * g4 + 4 * h2;
                    const float v0 = (j0 + 0 <= ii) ? a[4 * g4 + 0] : 0.f, v1 = (j0 + 1 <= ii) ? a[4 * g4 + 1] : 0.f, v2 = (j0 + 2 <= ii) ? a[4 * g4 + 2] : 0.f, v3 = (j0 + 3 <= ii) ? a[4 * g4 + 3] : 0.f;
                    unsigned long long pk = (unsigned long long)pkbf(v0, v1) | ((unsigned long long)pkbf(v2, v3) << 32);
                    *(LAS unsigned long long*)(AT + ii * 144 + j0 * 2) = pk; }
            }
            __syncthreads();
            f32x16 Z[2];
#pragma unroll
            for (int i = 0; i < 16; ++i) { Z[0][i] = 0.f; Z[1][i] = 0.f; }
#pragma unroll
            for (int mt = 0; mt < 4; ++mt)
#pragma unroll
                for (int s = 0; s < 2; ++s) { const bf16x8 Af = pack_acc(S[mt], s);
                    Z[0] = MFMA32(Af, perm_frag(QT, r, mt, s, h2), Z[0]); Z[1] = MFMA32(Af, perm_frag(QT, 32 + r, mt, s, h2), Z[1]); }
            bf16x8 Vf[4];
#pragma unroll
            for (int ks = 0; ks < 4; ++ks) Vf[ks] = tr_frag(VT + (w >> 2) * 16384, lane, 16 * ks, w & 3);
#pragma unroll
            for (int ks = 0; ks < 4; ++ks) {
                if (ks < 2) Z[0] = MFMA32(Vf[ks], *(const LAS bf16x8*)(AT + r * 144 + (16 * ks + 8 * h2) * 2), Z[0]);
                Z[1] = MFMA32(Vf[ks], *(const LAS bf16x8*)(AT + (32 + r) * 144 + (16 * ks + 8 * h2) * 2), Z[1]); }
#pragma unroll
            for (int tt = 0; tt < 2; ++tt) { float ss = 0.f;
#pragma unroll
                for (int i = 0; i < 16; ++i) ss = fmaf(Z[tt][i], Z[tt][i], ss);
                ss += __shfl_xor(ss, 32);
                if (lane < 32) red[w * 64 + 32 * tt + r] = ss; }
            __syncthreads();
#pragma unroll
            for (int tt = 0; tt < 2; ++tt) { float tsum = 0.f;
#pragma unroll
                for (int w2 = 0; w2 < 8; ++w2) tsum += red[w2 * 64 + 32 * tt + r];
                const float rs = 1.0f / sqrtf(tsum * (1.0f / GDV) + NORM_EPS);
                const size_t row = rowb + 32 * tt + r;
#pragma unroll
                for (int g4 = 0; g4 < 4; ++g4) { const int dv = 32 * w + 8 * g4 + 4 * h2; const f32x4 gg = *(const f32x4*)(F.gla_g + dv);
                    const unsigned long long gs = *(const GAS unsigned long long*)(F.PB + row * NPB + B_GS + hd * GDV + dv); const unsigned lo = (unsigned)gs, hi = (unsigned)(gs >> 32);
                    const unsigned long long o = (unsigned long long)pkbf(Z[tt][4 * g4] * rs * gg.x * bflo(lo), Z[tt][4 * g4 + 1] * rs * gg.y * bfhi(lo))
                                               | ((unsigned long long)pkbf(Z[tt][4 * g4 + 2] * rs * gg.z * bflo(hi), Z[tt][4 * g4 + 3] * rs * gg.w * bfhi(hi)) << 32);
                    *(GAS unsigned long long*)(F.ACAT + row * 2048 + hd * GDV + dv) = o; } }
#pragma unroll
            for (int ks = 0; ks < 4; ++ks)
#pragma unroll
                for (int mt = 0; mt < 4; ++mt) S[mt] = MFMA32(tr_frag(KT, lane, 16 * ks, mt), Vf[ks], S[mt]);
#pragma unroll
            for (int mt = 0; mt < 4; ++mt)
#pragma unroll
                for (int i = 0; i < 16; ++i) S[mt][i] *= dvec[32 * mt + crow(i, h2)];
        }
    }
}


constexpr size_t OUT_PART = 0;
constexpr size_t OUT_PL = 192 * MiB;
constexpr int LDS_QLIST = 131072 + 1024, LDS_QCNT = LDS_QLIST + 8192;
constexpr int M2_SEG = 2048;

__device__ __forceinline__ bf16x8 tr_frag_perm(LAS unsigned char* tile, int lane, int rowbase, int c) {
    const unsigned h = lane >> 5, blk = (lane >> 4) & 1, q = (lane & 15) >> 2, p = lane & 3;
    const unsigned a0 = off_b(rowbase + 4 * h + q, 4 * c + 2 * blk + (p >> 1)) + 8 * (p & 1);
    const unsigned a1 = off_b(rowbase + 8 + 4 * h + q, 4 * c + 2 * blk + (p >> 1)) + 8 * (p & 1);
    const s16x4 lo = __builtin_amdgcn_ds_read_tr16_b64_v4i16((LAS s16x4*)(tile + a0));
    const s16x4 hi = __builtin_amdgcn_ds_read_tr16_b64_v4i16((LAS s16x4*)(tile + a1));
    return __builtin_shufflevector(lo, hi, 0, 1, 2, 3, 4, 5, 6, 7);
}
__device__ __forceinline__ float moba_mfix(Frame& F) {
    float a = fmaxf(fabsf(F.qn_g[F.lane]), fabsf(F.qn_g[64 + F.lane])), b = fmaxf(fabsf(F.kn_g[F.lane]), fabsf(F.kn_g[64 + F.lane]));
    a = wave_max(a); b = wave_max(b);
    return 11.3137085f * a * b * 1.03f * 1.44269504089f;
}
__device__ __forceinline__ void moba_stage_kv(Frame& F, size_t row0, int hd) {
    const int tid = F.tid;
#pragma unroll 4
    for (int i = tid; i < 4096; i += 512) { const int row = i >> 4, ch = i & 15; const bf16* p = F.PA + (row0 + row) * NPA + hd * MDH + ch * 8;
        *(LAS v4u*)(F.lds + off_b(row, ch)) = *(const GAS v4u*)(p + A_MK); *(LAS v4u*)(F.lds + 65536 + off_b(row, ch)) = *(const GAS v4u*)(p + A_MV); }
}
template <bool CAUSAL>
__device__ __forceinline__ void moba_core(LAS unsigned char* Kt, LAS unsigned char* Vt, const bf16* qrow, int lane, int nkt, int wdiag, float c_t, float slope2, float keybase, f32x16 (&O)[4], float& l) {
    const int h2 = lane >> 5, r = lane & 31;
    bf16x8 Qf[8];
#pragma unroll
    for (int s = 0; s < 8; ++s) Qf[s] = *(const GAS bf16x8*)(qrow + 16 * s + 8 * h2);
#pragma unroll
    for (int db = 0; db < 4; ++db)
#pragma unroll
        for (int i = 0; i < 16; ++i) O[db][i] = 0.f;
    l = 0.f;
#pragma unroll 1
    for (int kt = 0; kt < nkt; ++kt) {
        {
            f32x16 a;
#pragma unroll
            for (int i = 0; i < 16; ++i) a[i] = 0.f;
#pragma unroll
            for (int s = 0; s < 8; ++s) a = MFMA32(row_frag(Kt, 32 * kt + r, s, h2), Qf[s], a);
            const float kb = keybase + (float)(32 * kt + 4 * h2);
#pragma unroll
            for (int i = 0; i < 16; ++i) { const int cr = (i & 3) + 8 * (i >> 2);
                float p = __builtin_amdgcn_exp2f(fmaf(a[i], 0.127517430f, fmaf(slope2, kb + (float)cr, c_t)));
                if (CAUSAL) { if (kt == wdiag && cr + 4 * h2 > r) p = 0.f; }
                a[i] = p; l += p; }
#pragma unroll
            for (int s2 = 0; s2 < 2; ++s2) { const bf16x8 Pf = pack_acc(a, s2);
#pragma unroll
                for (int db = 0; db < 4; ++db) O[db] = MFMA32(tr_frag_perm(Vt, lane, 32 * kt + 16 * s2, db), Pf, O[db]); }
        }
    }
}
__device__ __forceinline__ void m2_sel(Frame& F, bf16* PART, float* PL) {
    const float M2 = moba_mfix(F);
    LAS unsigned* qlist = (LAS unsigned*)(F.lds + LDS_QLIST); LAS unsigned* qcnt = (LAS unsigned*)(F.lds + LDS_QCNT);
    const int w = F.wave;
    constexpr int NITEM = 280 * BATCH * MH;
    for (int L = F.vcu; L < NITEM; L += F.G) {
        const int bh = L % (BATCH * MH), m = L / (BATCH * MH);
        int s = 0, cum = 0;
#pragma unroll
        for (int ss = 1; ss < 8; ++ss) { const int cs = 63 * ss - 4 * ss * (ss - 1); if (m >= cs) { s = ss; cum = cs; } }
        const int j = m - cum, hd = bh % MH, b = bh / MH;
        const int q0 = (j + 1 + 8 * s) * MBLK, q1 = (q0 + M2_SEG < SEQ) ? q0 + M2_SEG : SEQ;
        int lane = F.lane; asm volatile("" : "+v"(lane));
        __syncthreads();
        if (F.tid == 0) *qcnt = 0u;
        moba_stage_kv(F, (size_t)b * SEQ + (size_t)j * MBLK, hd);
        __syncthreads();
        for (int t = q0 + F.tid; t < q1; t += 512) { const int4 s4 = *(const int4*)(F.SEL + (((size_t)bh * SEQ + t) * 4));
            const int slot = (s4.x == j) ? 0 : ((s4.y == j) ? 1 : ((s4.z == j) ? 2 : -1));
            if (slot >= 0) { const unsigned idx = atomicAdd((unsigned*)qcnt, 1u); qlist[idx] = (unsigned)t | ((unsigned)slot << 16); } }
        __syncthreads();
        const int n = (int)*qcnt;
        const float slope2 = __builtin_amdgcn_exp2f(-(float)(hd + 1)) * 1.44269504089f;
        for (int base = 0; base < n; base += 256) {
            if (base + 32 * w < n) {
                const int idx = base + 32 * w + (lane & 31); const bool valid = idx < n;
                const unsigned e = qlist[valid ? idx : base + 32 * w]; const int t = (int)(e & 0xffffu), slot = (int)(e >> 16);
                f32x16 O[4]; float l;
                moba_core<false>(F.lds, F.lds + 65536, F.PA + ((size_t)b * SEQ + t) * NPA + A_MQ + hd * MDH, lane, 8, 0, -slope2 * (float)t - M2, slope2, (float)(j * MBLK), O, l);
                l += __shfl_xor(l, 32);
                if (valid) { const size_t pr = ((size_t)bh * SEQ + t) * 3 + slot; bf16* po = PART + pr * MDH + 4 * (lane >> 5);
#pragma unroll
                    for (int db = 0; db < 4; ++db)
#pragma unroll
                        for (int g4 = 0; g4 < 4; ++g4) *(GAS unsigned long long*)(po + 32 * db + 8 * g4) = (unsigned long long)pkbf(O[db][4 * g4], O[db][4 * g4 + 1]) | ((unsigned long long)pkbf(O[db][4 * g4 + 2], O[db][4 * g4 + 3]) << 32);
                    if (lane < 32) PL[((size_t)bh * SEQ + t) * 4 + slot] = l; }
            }
        }
    }
}
__device__ __forceinline__ void m3_own(Frame& F, const bf16* PART, const float* PL) {
    const float M2 = moba_mfix(F);
    const int w = F.wave;
    for (int item = F.vcu; item < BATCH * MH * NBLK; item += F.G) {
        const int hd = item % MH, qb = (item / MH) % NBLK, b = item / (MH * NBLK), bh = b * MH + hd;
        int lane = F.lane; asm volatile("" : "+v"(lane));
        __syncthreads();
        moba_stage_kv(F, (size_t)b * SEQ + (size_t)qb * MBLK, hd);
        __syncthreads();
        const int t = qb * MBLK + 32 * w + (lane & 31);
        const float slope2 = __builtin_amdgcn_exp2f(-(float)(hd + 1)) * 1.44269504089f;
        f32x16 O[4]; float l;
        moba_core<true>(F.lds, F.lds + 65536, F.PA + ((size_t)b * SEQ + t) * NPA + A_MQ + hd * MDH, lane, w + 1, w, -slope2 * (float)t - M2, slope2, (float)(qb * MBLK), O, l);
        l += __shfl_xor(l, 32);
        const int4 s4 = *(const int4*)(F.SEL + (((size_t)bh * SEQ + t) * 4));
#pragma unroll
        for (int slot = 0; slot < 3; ++slot) { const int sj = slot == 0 ? s4.x : (slot == 1 ? s4.y : s4.z);
            if (sj >= 0) { const size_t pr = ((size_t)bh * SEQ + t) * 3 + slot; const bf16* po = PART + pr * MDH + 4 * (lane >> 5);
                l += PL[((size_t)bh * SEQ + t) * 4 + slot];
#pragma unroll
                for (int db = 0; db < 4; ++db)
#pragma unroll
                    for (int g4 = 0; g4 < 4; ++g4) { const unsigned long long v = *(const GAS unsigned long long*)(po + 32 * db + 8 * g4); const unsigned lo = (unsigned)v, hi = (unsigned)(v >> 32);
                        O[db][4 * g4] += bflo(lo); O[db][4 * g4 + 1] += bfhi(lo); O[db][4 * g4 + 2] += bflo(hi); O[db][4 * g4 + 3] += bfhi(hi); } } }
        const float inv = 1.0f / l;
        const size_t row = (size_t)b * SEQ + t;
        const bf16* gp = F.PB + row * NPB + B_MS + hd * MDH + 4 * (lane >> 5); bf16* op = F.ACAT + row * 2048 + 1024 + hd * MDH + 4 * (lane >> 5);
#pragma unroll
        for (int db = 0; db < 4; ++db)
#pragma unroll
            for (int g4 = 0; g4 < 4; ++g4) { const unsigned long long gs = *(const GAS unsigned long long*)(gp + 32 * db + 8 * g4); const unsigned lo = (unsigned)gs, hi = (unsigned)(gs >> 32);
                *(GAS unsigned long long*)(op + 32 * db + 8 * g4) = (unsigned long long)pkbf(O[db][4 * g4] * inv * bflo(lo), O[db][4 * g4 + 1] * inv * bfhi(lo))
                                                               | ((unsigned long long)pkbf(O[db][4 * g4 + 2] * inv * bflo(hi), O[db][4 * g4 + 3] * inv * bfhi(hi)) << 32); }
    }
}

constexpr int N_PHASES = 11;
#ifndef MK_N_LAUNCHES
#define MK_N_LAUNCHES 1
#endif
struct Args { const float* in[11]; float* out; unsigned char* ws; int ph_lo, ph_hi; };
__global__ void __launch_bounds__(NWAVES * 64, 2) mk_fwd(Args args) {
    extern __shared__ __attribute__((aligned(16))) unsigned char lds[];
    Frame F;
    F.lds = (LAS unsigned char*)lds;
    F.tid = threadIdx.x; F.lane = F.tid & 63; F.wave = __builtin_amdgcn_readfirstlane(F.tid >> 6);
    F.G = gridDim.x; { const int bx = blockIdx.x; F.vcu = (F.G % 8 == 0) ? (bx % 8) * (F.G / 8) + bx / 8 : bx; }
    unsigned char* ws = args.ws;
    F.x = args.in[0]; F.norm_g = args.in[1]; F.w_in = args.in[2]; F.w_gate = args.in[3]; F.b_gate = args.in[4]; F.gla_g = args.in[5];
    F.qn_g = args.in[6]; F.kn_g = args.in[7]; F.w_bg = args.in[8]; F.w_bm = args.in[9]; F.w_out = args.in[10]; F.out = args.out;
    F.WIN = (bf16*)(ws + WS_WIN); F.WCAT = (bf16*)(ws + WS_WCAT); F.WOUT = (bf16*)(ws + WS_WOUT); F.XN = (bf16*)(ws + WS_XN); F.ACAT = (bf16*)(ws + WS_ACAT);
    F.PA = (bf16*)(ws + WS_PA); F.PB = (bf16*)(ws + WS_PB); F.MG = (bf16*)(ws + WS_MG);
    F.GLR = (float*)(ws + WS_GLR); F.KMEAN = (float*)(ws + WS_KMEAN); F.OG = args.out; F.SEL = (int*)(ws + WS_SEL);
    volatile LAS unsigned* MISC = (volatile LAS unsigned*)(F.lds + MISC_OFF);
    for (int u = F.tid; u < (LDS_BYTES - LDSCTL_OFF) / 4; u += NWAVES * 64) ((LAS unsigned*)(F.lds + LDSCTL_OFF))[u] = 0u;
    __syncthreads();
    const int lo = args.ph_lo, hi = args.ph_hi;
    XcdBarrier bar; bar.bar = (unsigned*)(ws + WS_CTL) + CW_BAR; bar.x = 0; bar.st = nullptr;
    if (hi - lo > 1) bar = xcd_barrier_post((unsigned*)(ws + WS_CTL) + CW_BAR, MISC + 8);
#ifndef PH_MASK
#define PH_MASK 0x7ff
#endif
#define IN(k) (((PH_MASK >> (k)) & 1) && lo <= (k) && (k) < hi)
#define SEAM(k) do { if (IN(k) && IN((k) + 1)) xcd_barrier(bar); } while (0)

    if (IN(0)) { p0_prologue(F); } SEAM(0);
    if (IN(1)) {
        pg8::Gemm g{F.XN, F.WIN, T, NP, DM}; pg8::StaticOrder S; S.init(T, NP, F.G, (int)blockIdx.x);
        pg8::EpiProj E{F.PA, F.PB, F.GLR};
        pg8::gemm_phase<pg8::EpiProj, pg8::StaticOrder, true, true>(F.lds + RING_OFF, g, S, E);
    } SEAM(1);
    if (IN(2)) { m0_qknorm(F); } SEAM(2);
    if (IN(3)) { m1_select(F); } SEAM(3);
    if (IN(4)) { m2_sel(F, (bf16*)((unsigned char*)args.out + OUT_PART), (float*)((unsigned char*)args.out + OUT_PL)); } SEAM(4);
    if (IN(5)) { m3_own(F, (const bf16*)((unsigned char*)args.out + OUT_PART), (const float*)((unsigned char*)args.out + OUT_PL)); } SEAM(5);
    if (IN(6)) { gla_g1(F, (float*)(ws + WS_DEC), (float*)(ws + WS_DG), (float*)(ws + WS_ULOC)); } SEAM(6);
    if (IN(7)) { gla_g2(F, (const float*)(ws + WS_DG), (float*)(ws + WS_ULOC)); } SEAM(7);
    if (IN(8)) { gla_g3(F, (const float*)(ws + WS_DEC), (const float*)(ws + WS_ULOC)); } SEAM(8);
    if (IN(9)) {
        pg8::Gemm g{F.ACAT, F.WCAT, T, DM, 2048}; pg8::StaticOrder S; S.init(T, DM, F.G, (int)blockIdx.x);
        pg8::EpiMerge E{F.PB, F.MG};
        pg8::gemm_phase<pg8::EpiMerge, pg8::StaticOrder, true, true>(F.lds + RING_OFF, g, S, E);
    } SEAM(9);
    if (IN(10)) {
        pg8::Gemm g{F.MG, F.WOUT, T, DM, DM}; pg8::StaticOrder S; S.init(T, DM, F.G, (int)blockIdx.x);
        pg8::EpiOut E{F.x, F.out};
        pg8::gemm_phase<pg8::EpiOut, pg8::StaticOrder, true, true>(F.lds + RING_OFF, g, S, E);
    }
#undef IN
#undef SEAM
}

extern "C" void kernel_launch(void* const* d_in, const int* in_sizes, int n_in, void* d_out, int out_size, void* d_ws, size_t ws_size, hipStream_t stream) {
    static int grid = 0;
    if (grid == 0) {
        if (n_in != 11 || in_sizes[0] != T * DM || out_size != T * DM || ws_size < WS_END) { fprintf(stderr, "kernel_launch: unexpected shapes (n_in %d, in0 %d, out %d, ws %zu)\n", n_in, n_in > 0 ? in_sizes[0] : -1, out_size, ws_size); grid = -1; return; }
        int dev = 0, cus = 0, per_cu = 0;
        if (hipGetDevice(&dev) != hipSuccess || hipDeviceGetAttribute(&cus, hipDeviceAttributeMultiprocessorCount, dev) != hipSuccess) { grid = -1; return; }
        if (hipFuncSetAttribute((const void*)mk_fwd, hipFuncAttributeMaxDynamicSharedMemorySize, LDS_BYTES) != hipSuccess) { fprintf(stderr, "kernel_launch: hipFuncSetAttribute failed\n"); grid = -1; return; }
        if (hipOccupancyMaxActiveBlocksPerMultiprocessor(&per_cu, (const void*)mk_fwd, NWAVES * 64, LDS_BYTES) != hipSuccess || per_cu < 1) { fprintf(stderr, "kernel_launch: occupancy query says %d blocks per CU\n", per_cu); per_cu = 1; }
        (void)hipGetLastError();
        grid = cus;
    }
    if (grid < 0) return;
    (void)hipMemsetAsync((char*)d_ws + WS_CTL, 0, CTL_ZERO_BYTES, stream);
    Args a{};
    for (int i = 0; i < 11; ++i) a.in[i] = (const float*)d_in[i];
    a.out = (float*)d_out; a.ws = (unsigned char*)d_ws;
    constexpr int NL = MK_N_LAUNCHES;
    for (int li = 0; li < NL; ++li) {
        a.ph_lo = (NL == 1) ? 0 : li; a.ph_hi = (NL == 1) ? N_PHASES : li + 1;
        void* kargs[] = {(void*)&a};
        hipError_t e = hipLaunchCooperativeKernel((const void*)mk_fwd, dim3(grid), dim3(NWAVES * 64), kargs, LDS_BYTES, stream);
        if (e != hipSuccess) { fprintf(stderr, "kernel_launch: cooperative launch failed: %s (grid %d)\n", hipGetErrorString(e), grid); (void)hipGetLastError(); }
    }
}
```

```cpp
#include <hip/hip_runtime.h>
#include <cstdio>
#include <cstdint>
namespace pg8 {
#define PG8_LAS __attribute__((address_space(3)))
typedef unsigned short bf16_t;
typedef short bf16x8 __attribute__((ext_vector_type(8)));
typedef float f32x4 __attribute__((ext_vector_type(4)));
typedef unsigned u32x4 __attribute__((ext_vector_type(4)));
constexpr int BM = 256, BK = 64, HALF = 128, HTB = HALF * BK * 2  , STAGE_BYTES = 8 * HTB, NXCD = 8, WGM = 8;

__host__ __device__ __forceinline__ int lds_byte(int r, int c) { const int st = (r >> 4) * 2 + (c >> 5), rr = r & 15, cc = c & 31, ob = rr * 64 + cc * 2; return st * 1024 + (ob ^ (((ob >> 9) & 1) << 5)); }
__host__ __device__ __forceinline__ void stage_rc(int b, int& R, int& C) { const int st = b / 1024, sb = b % 1024, swz = sb ^ (((sb >> 9) & 1) << 5); R = (st >> 1) * 16 + swz / 64; C = (st & 1) * 32 + (swz % 64) / 2; }
__host__ __device__ __forceinline__ int perm32(int rho) { const int n = rho >> 4, i = rho & 15; return 8 * (i >> 2) + 4 * n + (i & 3); }

struct Unit { int pm, pn; };
struct Gemm { const bf16_t* A; const bf16_t* Bt; int M, N, K; };

struct StaticOrder {
    int nM, nN, nwg, G, c, dup;
    __host__ __device__ void init(int M, int N, int G_, int c_, int dup_ = 1) { nM = M / BM; nN = N / BM; nwg = nM * nN; G = G_; c = c_; dup = dup_; }
    __host__ __device__ bool next(int i, Unit& u) const {
        const long L = (long)(i / dup) * G + c; if (L >= nwg) return false;
        int wgid = (int)L; { const int q = nwg / NXCD, r = nwg % NXCD, xcd = wgid % NXCD, off = wgid / NXCD; wgid = (xcd < r ? xcd * (q + 1) : r * (q + 1) + (xcd - r) * q) + off; }
        const int nig = WGM * nN, gid = wgid / nig, fm = gid * WGM, gsz = (nM - fm) < WGM ? (nM - fm) : WGM;
        u.pm = fm + ((wgid % nig) % gsz); u.pn = (wgid % nig) / gsz; return true;
    }
    __device__ __forceinline__ void a_ready(const Unit&) const {}
    __device__ __forceinline__ void done(const Unit&) const {}
};

__device__ __forceinline__ unsigned cvt_pk_bf16(float lo, float hi) { unsigned r; asm volatile("v_cvt_pk_bf16_f32 %0, %1, %2" : "=v"(r) : "v"(lo), "v"(hi)); return r; }

template <class Epi, class Sched, bool ALIGN_EPI = false, bool SP2 = false>
__device__ __forceinline__ void gemm_phase(PG8_LAS unsigned char* lds, const Gemm g, const Sched& S, const Epi& E) {
    const int tid = threadIdx.x, wid = __builtin_amdgcn_readfirstlane(tid >> 6), lane = tid & 63, wr = wid >> 2, wc = wid & 3, fr = lane & 15, fq = lane >> 4;
    const int K = g.K, nt = K / BK;
    unsigned voffA[2], voffB[2];
#pragma unroll
    for (int i = 0; i < 2; ++i) { int R, C; stage_rc(tid * 16 + i * 8192, R, C); const int Rb = Epi::PERM ? ((R & ~31) + perm32(R & 31)) : R;
        voffA[i] = (unsigned)(R * K + C) * 2u; voffB[i] = (unsigned)(Rb * K + C) * 2u; }
    const size_t kstep = (size_t)(BK * 2);
    const size_t hstep = (size_t)HALF * K * 2;
    const size_t tstep = 2 * hstep;
    const unsigned ldsw = (unsigned)wid * 1024u;
    const int aoff = lds_byte(wr * 64 + fr, fq * 8), boff = lds_byte(wc * 32 + fr, fq * 8);
#define PG8_SA(b, h) (((b) * 2 + (h)) * HTB)
#define PG8_SB(b, h) ((4 + (b) * 2 + (h)) * HTB)
#define PG8_STAGE(bufoff, gbase, voff) do { _Pragma("unroll") for (int _i = 0; _i < 2; ++_i) \
        __builtin_amdgcn_global_load_lds((const unsigned*)((const char*)(gbase) + (voff)[_i]), (PG8_LAS unsigned*)(lds + (bufoff) + ldsw + _i * 8192), 16, 0, 0); } while (0)
#define PG8_LDA(dst, b, h) do { _Pragma("unroll") for (int m = 0; m < 4; ++m) _Pragma("unroll") for (int k = 0; k < 2; ++k) dst[m][k] = *(const PG8_LAS bf16x8*)(lds + PG8_SA(b, h) + aoff + m * 2048 + k * 1024); } while (0)
#define PG8_LDB(dst, b, h) do { _Pragma("unroll") for (int n = 0; n < 2; ++n) _Pragma("unroll") for (int k = 0; k < 2; ++k) dst[n][k] = *(const PG8_LAS bf16x8*)(lds + PG8_SB(b, h) + boff + n * 2048 + k * 1024); } while (0)
#define PG8_MMA(ai, bj, At, Bt) do { __builtin_amdgcn_s_setprio(1); _Pragma("unroll") for (int m = 0; m < 4; ++m) _Pragma("unroll") for (int n = 0; n < 2; ++n) _Pragma("unroll") for (int k = 0; k < 2; ++k) \
        acc[ai][bj][m][n] = __builtin_amdgcn_mfma_f32_16x16x32_bf16(Bt[n][k], At[m][k], acc[ai][bj][m][n], 0, 0, 0); __builtin_amdgcn_s_setprio(0); } while (0)
#define PG8_WAIT_V(n) asm volatile("s_waitcnt vmcnt(" #n ")" ::: "memory")
#define PG8_WAIT_L(n) asm volatile("s_waitcnt lgkmcnt(" #n ")" ::: "memory")
#define PG8_BAR __builtin_amdgcn_s_barrier()
#define PG8_SCHED __builtin_amdgcn_sched_barrier(0)
    Unit cur, nxt; int ui = 0;
    if (!S.next(0, cur)) return;
    f32x4 acc[2][2][4][2];
#pragma unroll
    for (int a = 0; a < 2; ++a)
#pragma unroll
        for (int b = 0; b < 2; ++b)
#pragma unroll
            for (int m = 0; m < 4; ++m)
#pragma unroll
                for (int n = 0; n < 2; ++n) acc[a][b][m][n] = (f32x4){0.f, 0.f, 0.f, 0.f};
    bf16x8 At[4][2], B0[2][2], B1[2][2];
    const char* cA = (const char*)g.A + (size_t)cur.pm * tstep; const char* cB = (const char*)g.Bt + (size_t)cur.pn * tstep;
    S.a_ready(cur);
    if constexpr (SP2) {
        PG8_STAGE(PG8_SB(0, 0), cB, voffB); PG8_STAGE(PG8_SB(0, 1), cB + hstep, voffB); PG8_STAGE(PG8_SA(0, 0), cA, voffA); PG8_STAGE(PG8_SA(0, 1), cA + hstep, voffA);
        if (wr == 1) PG8_BAR;
        PG8_WAIT_V(2); PG8_BAR;
        PG8_STAGE(PG8_SB(1, 0), cB + kstep, voffB); PG8_STAGE(PG8_SA(1, 0), cA + kstep, voffA); PG8_STAGE(PG8_SB(1, 1), cB + hstep + kstep, voffB);
        PG8_WAIT_V(6); PG8_BAR;
    } else {
        PG8_STAGE(PG8_SB(0, 0), cB, voffB); PG8_STAGE(PG8_SA(0, 0), cA, voffA); PG8_STAGE(PG8_SB(0, 1), cB + hstep, voffB); PG8_STAGE(PG8_SA(0, 1), cA + hstep, voffA);
        if (wr == 1) PG8_BAR;
        PG8_WAIT_V(4); PG8_BAR;
        PG8_STAGE(PG8_SB(1, 0), cB + kstep, voffB); PG8_STAGE(PG8_SA(1, 0), cA + kstep, voffA); PG8_STAGE(PG8_SB(1, 1), cB + hstep + kstep, voffB);
        PG8_WAIT_V(6); PG8_BAR;
    }
    for (;;) {
        const bool has_next = S.next(ui + 1, nxt);
        const char* nA = has_next ? (const char*)g.A + (size_t)nxt.pm * tstep : cA; const char* nB = has_next ? (const char*)g.Bt + (size_t)nxt.pn * tstep : cB;
        for (int t = 0; t < nt; t += 2) {
            if constexpr (Epi::MID_HOOK) { if (t == nt / 2) E.mid(acc, cur, wr, wc, fr, fq); }
            const bool last = (t == nt - 2);
            const char* a1 = cA + (size_t)(t + 1) * kstep;
            const char* a2 = last ? nA : cA + (size_t)(t + 2) * kstep; const char* b2 = last ? nB : cB + (size_t)(t + 2) * kstep;
            const char* a3 = a2 + kstep; const char* b3 = b2 + kstep;
            if (last && has_next) S.a_ready(nxt);
            if constexpr (SP2) {
            PG8_LDB(B0, 0, 0); PG8_LDB(B1, 0, 1); PG8_SCHED; PG8_LDA(At, 0, 0); PG8_STAGE(PG8_SA(1, 1), a1 + hstep, voffA);
            PG8_WAIT_V(8); PG8_WAIT_L(0); PG8_BAR; PG8_MMA(0, 0, At, B0); PG8_MMA(0, 1, At, B1); PG8_BAR; PG8_SCHED;
            PG8_LDA(At, 0, 1); PG8_STAGE(PG8_SB(0, 0), b2, voffB); PG8_STAGE(PG8_SB(0, 1), b2 + hstep, voffB); PG8_STAGE(PG8_SA(0, 0), a2, voffA);
            PG8_WAIT_V(8); PG8_WAIT_L(0); PG8_BAR; PG8_MMA(1, 0, At, B0); PG8_MMA(1, 1, At, B1); PG8_BAR; PG8_SCHED;
            PG8_LDB(B0, 1, 0); PG8_LDB(B1, 1, 1); PG8_SCHED; PG8_LDA(At, 1, 0); PG8_STAGE(PG8_SA(0, 1), a2 + hstep, voffA);
            PG8_WAIT_V(8); PG8_WAIT_L(0); PG8_BAR; PG8_MMA(0, 0, At, B0); PG8_MMA(0, 1, At, B1); PG8_BAR; PG8_SCHED;
            PG8_LDA(At, 1, 1); PG8_STAGE(PG8_SB(1, 0), b3, voffB); PG8_STAGE(PG8_SB(1, 1), b3 + hstep, voffB); PG8_STAGE(PG8_SA(1, 0), a3, voffA);
            PG8_WAIT_V(8); PG8_WAIT_L(0); PG8_BAR; PG8_MMA(1, 0, At, B0); PG8_MMA(1, 1, At, B1); PG8_BAR; PG8_SCHED;
            } else {
            PG8_LDB(B0, 0, 0); PG8_SCHED; PG8_LDA(At, 0, 0); PG8_STAGE(PG8_SA(1, 1), a1 + hstep, voffA);
            PG8_WAIT_L(8); PG8_BAR; PG8_WAIT_L(0); PG8_MMA(0, 0, At, B0); PG8_BAR; PG8_SCHED;
            PG8_LDB(B1, 0, 1); PG8_STAGE(PG8_SB(0, 0), b2, voffB);
            PG8_BAR; PG8_WAIT_L(0); PG8_MMA(0, 1, At, B1); PG8_BAR;
            PG8_LDA(At, 0, 1); PG8_STAGE(PG8_SA(0, 0), a2, voffA);
            PG8_BAR; PG8_WAIT_L(0); PG8_MMA(1, 0, At, B0); PG8_BAR; PG8_SCHED;
            PG8_STAGE(PG8_SB(0, 1), b2 + hstep, voffB);
            PG8_WAIT_V(6); PG8_BAR; PG8_MMA(1, 1, At, B1); PG8_BAR;
            PG8_LDB(B0, 1, 0); PG8_SCHED; PG8_LDA(At, 1, 0); PG8_STAGE(PG8_SA(0, 1), a2 + hstep, voffA);
            PG8_WAIT_L(8); PG8_BAR; PG8_WAIT_L(0); PG8_MMA(0, 0, At, B0); PG8_BAR; PG8_SCHED;
            PG8_LDB(B1, 1, 1); PG8_STAGE(PG8_SB(1, 0), b3, voffB);
            PG8_BAR; PG8_WAIT_L(0); PG8_MMA(0, 1, At, B1); PG8_BAR;
            PG8_LDA(At, 1, 1); PG8_STAGE(PG8_SA(1, 0), a3, voffA);
            PG8_BAR; PG8_WAIT_L(0); PG8_MMA(1, 0, At, B0); PG8_BAR; PG8_SCHED;
            PG8_STAGE(PG8_SB(1, 1), b3 + hstep, voffB);
            PG8_WAIT_V(6); PG8_BAR; PG8_MMA(1, 1, At, B1); PG8_BAR;
            }
        }
        if constexpr (ALIGN_EPI) { if (wr == 0) PG8_BAR; }
        if constexpr (!Epi::AFTER_DRAIN) { E(acc, cur, wr, wc, fr, fq); S.done(cur); }
        if (!has_next) break;
#pragma unroll
        for (int a = 0; a < 2; ++a)
#pragma unroll
            for (int b = 0; b < 2; ++b)
#pragma unroll
                for (int m = 0; m < 4; ++m)
#pragma unroll
                    for (int n = 0; n < 2; ++n) acc[a][b][m][n] = (f32x4){0.f, 0.f, 0.f, 0.f};
        cur = nxt; cA = nA; cB = nB; ++ui;
        if constexpr (ALIGN_EPI) { if (wr == 1) PG8_BAR; }
    }
    PG8_WAIT_V(0);
    if constexpr (!ALIGN_EPI) { if (wr == 0) PG8_BAR; }
    PG8_BAR;
    if constexpr (Epi::AFTER_DRAIN) { E.fused(acc, cur, wr, wc, fr, fq, lds, wid, lane); S.done(cur); }
#undef PG8_SA
#undef PG8_SB
#undef PG8_STAGE
#undef PG8_LDA
#undef PG8_LDB
#undef PG8_MMA
#undef PG8_WAIT_V
#undef PG8_WAIT_L
#undef PG8_BAR
#undef PG8_SCHED
}
}
#define GAS __attribute__((address_space(1)))
#define LAS __attribute__((address_space(3)))
typedef unsigned short bf16;
typedef unsigned v4u __attribute__((ext_vector_type(4)));
typedef float f32x4 __attribute__((ext_vector_type(4)));
typedef short bf16x8 __attribute__((ext_vector_type(8)));
typedef GAS unsigned gu32;
typedef GAS unsigned long long gu64;
#define RLX_AGENT __ATOMIC_RELAXED, __HIP_MEMORY_SCOPE_AGENT
#define LDS_WAIT() asm volatile("s_waitcnt lgkmcnt(0)" ::: "memory")
#define VM_WAIT() asm volatile("s_waitcnt vmcnt(0)" ::: "memory")
__device__ __forceinline__ unsigned long long rt() { return __builtin_amdgcn_s_memrealtime(); }
__device__ __forceinline__ unsigned f2bf(float f) { unsigned u = __builtin_bit_cast(unsigned, f); return (u + 0x7fffu + ((u >> 16) & 1u)) >> 16; }
__device__ __forceinline__ unsigned pk2(float lo, float hi) { return f2bf(lo) | (f2bf(hi) << 16); }

#define XB_TMO      128
#define XB_XCNT(j)  (256  + 64 * (j))
#define XB_XSUB(j)  (1280 + 64 * (j))
#define XB_XGEN(j)  (2304 + 64 * (j))
#define XB_TOP      3328
#define XB_TOPGEN   3392
#define XCD_BAR_WORDS 3456
#define XB_SPIN_CAP (1u << 24)

__device__ __forceinline__ unsigned xb_ld(unsigned* p)              { return __hip_atomic_load(p, __ATOMIC_RELAXED, __HIP_MEMORY_SCOPE_AGENT); }
__device__ __forceinline__ unsigned xb_add(unsigned* p, unsigned v) { return __hip_atomic_fetch_add(p, v, __ATOMIC_RELAXED, __HIP_MEMORY_SCOPE_AGENT); }
__device__ __forceinline__ unsigned xb_xcc_id() { return (unsigned)__builtin_amdgcn_s_getreg((3 << 11) | 20) & 0xFu; }
#define XB_SPIN(cond, bar) do { unsigned _sp = 0; while (cond) { __builtin_amdgcn_s_sleep(1); \
    if ((++_sp & 255u) == 0u) { if (xb_ld(&(bar)[XB_TMO])) break; if (_sp > XB_SPIN_CAP) { atomicAdd(&(bar)[XB_TMO], 1u); break; } } } } while (0)

struct XcdBarrier {
    unsigned* bar; unsigned x;
    volatile LAS unsigned* st;
};

__device__ __forceinline__ XcdBarrier xcd_barrier_post(unsigned* bar, volatile LAS unsigned* st) {
    XcdBarrier b; b.bar = bar; b.x = xb_xcc_id(); b.st = st;
    if (threadIdx.x == 0) (void)xb_add(&bar[XB_XCNT(b.x)], 1u);
    return b;
}
__device__ __forceinline__ void xcd_barrier_complete(unsigned* bar, unsigned x, unsigned& nloc, unsigned& nx) {
    const unsigned G = gridDim.x * gridDim.y * gridDim.z;
    unsigned sum, cnt, mine, sp = 0u;
    for (;;) {
        sum = 0u; cnt = 0u; mine = 0u;
#pragma unroll
        for (unsigned j = 0; j < 16; ++j) { const unsigned c = xb_ld(&bar[XB_XCNT(j)]); sum += c; cnt += (c > 0u) ? 1u : 0u; mine = (j == x) ? c : mine; }
        if (sum == G) break;
        __builtin_amdgcn_s_sleep(1);
        if ((++sp & 255u) == 0u) { if (xb_ld(&bar[XB_TMO])) break; if (sp > XB_SPIN_CAP) { atomicAdd(&bar[XB_TMO], 1u); break; } }
    }
    nloc = mine > 0u ? mine : 1u; nx = cnt > 0u ? cnt : 1u;
}

__device__ __forceinline__ void xcd_barrier(const XcdBarrier& b) {
    asm volatile("s_waitcnt vmcnt(0)" ::: "memory");
    __syncthreads();
    if (threadIdx.x == 0) {
        unsigned* bar = b.bar;
        __builtin_amdgcn_s_waitcnt(0);
        unsigned nloc = b.st[0], nx = b.st[1];
        if (nloc == 0u) { xcd_barrier_complete(bar, b.x, nloc, nx); b.st[0] = nloc; b.st[1] = nx; }
        const unsigned old = xb_add(&bar[XB_XSUB(b.x)], 1u);
        const unsigned gen = old / nloc;
        if (old + 1u == (gen + 1u) * nloc) {
            __builtin_amdgcn_fence(__ATOMIC_RELEASE, "agent");
            asm volatile("s_waitcnt vmcnt(0)" ::: "memory");
            const unsigned og = xb_add(&bar[XB_TOP], 1u);
            const unsigned tg = og / nx;
            if (og + 1u == (tg + 1u) * nx) xb_add(&bar[XB_TOPGEN], 1u);
            else XB_SPIN(xb_ld(&bar[XB_TOPGEN]) == tg, bar);
            __builtin_amdgcn_fence(__ATOMIC_ACQUIRE, "agent");
            xb_add(&bar[XB_XGEN(b.x)], 1u);
            asm volatile("s_waitcnt vmcnt(0)" ::: "memory");
        } else {
            XB_SPIN(xb_ld(&bar[XB_XGEN(b.x)]) == gen, bar);
            __builtin_amdgcn_fence(__ATOMIC_ACQUIRE, "agent");
            asm volatile("s_waitcnt vmcnt(0)" ::: "memory");
        }
    }
    __syncthreads();
}

constexpr int NWAVES = 8;
constexpr int BATCH = 2, SEQ = 16384, DM = 2048, T = BATCH * SEQ;
constexpr int GH = 4, GDK = 128, GDV = 256, GWK = 512, GWV = 1024, GRANK = 16;
constexpr int MH = 8, MDH = 128, MW = 1024, MBLK = 256, NBLK = SEQ / MBLK;
constexpr int NSRC = 11280;
constexpr int NPA = 5120, NPB = 6144;
constexpr int NP = 11520;
constexpr float NORM_EPS = 1e-6f;
constexpr int A_GQ = 0, A_GK = 512, A_GV = 1024, A_MQ = 2048, A_MK = 3072, A_MV = 4096;
constexpr int B_GS = 0, B_MS = 1024, B_GA = 2048, B_GB = 4096;

constexpr size_t MiB = 1u << 20;
constexpr size_t WS_CTL = 0, CTL_ZERO_BYTES = 1 * MiB;
constexpr size_t WS_KMEAN = 1 * MiB;
constexpr size_t WS_WIN = 2 * MiB;
constexpr size_t WS_WCAT = 47 * MiB;
constexpr size_t WS_WOUT = 55 * MiB;
constexpr size_t WS_GLR = 63 * MiB;
constexpr size_t WS_SEL = 65 * MiB;
constexpr size_t WS_XN = 70 * MiB;
constexpr size_t WS_ACAT = WS_XN;
constexpr size_t WS_PA = 198 * MiB;
constexpr size_t WS_MG = WS_PA;
constexpr size_t WS_PB = 518 * MiB;
constexpr size_t WS_DEC = 902 * MiB;
constexpr size_t WS_DG = 904 * MiB;
constexpr size_t WS_ULOC = 906 * MiB;
constexpr size_t WS_END = 938 * MiB;

constexpr int CW_BAR = 4096;

constexpr int RING_OFF = 0, RING_BYTES = 131072;
constexpr int LDSCTL_OFF = RING_BYTES, MISC_OFF = LDSCTL_OFF + 320;
constexpr int LDS_BYTES = 147456;

__device__ __forceinline__ float bflo(unsigned u) { return __builtin_bit_cast(float, u << 16); }
__device__ __forceinline__ float bfhi(unsigned u) { return __builtin_bit_cast(float, u & 0xffff0000u); }
__device__ __forceinline__ float bf2f(unsigned short u) { return __builtin_bit_cast(float, (unsigned)u << 16); }
__device__ __forceinline__ float sigmoidf_(float v) { return __builtin_amdgcn_rcpf(1.0f + __builtin_amdgcn_exp2f(-1.44269504089f * v)); }
__device__ __forceinline__ float wave_sum(float v) {
#pragma unroll
    for (int o = 1; o < 64; o <<= 1) v += __shfl_xor(v, o);
    return v;
}
__device__ __forceinline__ float wave_max(float v) {
#pragma unroll
    for (int o = 1; o < 64; o <<= 1) v = fmaxf(v, __shfl_xor(v, o));
    return v;
}

namespace pg8 {
struct EpiProj {
    static constexpr bool PERM = true, AFTER_DRAIN = false, MID_HOOK = false;
    bf16_t* PA; bf16_t* PB; float* GLR;
    __device__ __forceinline__ void operator()(const f32x4 (&acc)[2][2][4][2], const Unit& u, int wr, int wc, int fr, int fq) const {
        const int pn = u.pn, row0 = u.pm * BM + wr * 64 + fr;
        if (pn < 20) {
            const float sc = pn < 2 ? 0.08838834764831845f : 1.0f;
            const int col0 = pn * BM + wc * 32 + 8 * fq;
#pragma unroll
            for (int ai = 0; ai < 2; ++ai)
#pragma unroll
                for (int m = 0; m < 4; ++m) { bf16_t* rowp = PA + (size_t)(row0 + ai * HALF + m * 16) * NPA + col0;
#pragma unroll
                    for (int bj = 0; bj < 2; ++bj) { const f32x4 v0 = acc[ai][bj][m][0] * sc, v1 = acc[ai][bj][m][1] * sc;
                        u32x4 w; w.x = cvt_pk_bf16(v0[0], v0[1]); w.y = cvt_pk_bf16(v0[2], v0[3]); w.z = cvt_pk_bf16(v1[0], v1[1]); w.w = cvt_pk_bf16(v1[2], v1[3]);
                        *(u32x4*)(rowp + bj * HALF) = w; } }
        } else if (pn < 44) {
            const bool is_silu = pn < 28;
            const int col0 = (pn - 20) * BM + wc * 32 + 8 * fq;
#pragma unroll
            for (int ai = 0; ai < 2; ++ai)
#pragma unroll
                for (int m = 0; m < 4; ++m) { bf16_t* rowp = PB + (size_t)(row0 + ai * HALF + m * 16) * NPB + col0;
#pragma unroll
                    for (int bj = 0; bj < 2; ++bj) { float v[8];
#pragma unroll
                        for (int i = 0; i < 4; ++i) { v[i] = acc[ai][bj][m][0][i]; v[4 + i] = acc[ai][bj][m][1][i]; }
#pragma unroll
                        for (int i = 0; i < 8; ++i) { const float s = sigmoidf_(v[i]); v[i] = is_silu ? v[i] * s : s; }
                        u32x4 w; w.x = cvt_pk_bf16(v[0], v[1]); w.y = cvt_pk_bf16(v[2], v[3]); w.z = cvt_pk_bf16(v[4], v[5]); w.w = cvt_pk_bf16(v[6], v[7]);
                        *(u32x4*)(rowp + bj * HALF) = w; } }
        } else {
            if (wc == 0 && fq < 2) {
#pragma unroll
                for (int ai = 0; ai < 2; ++ai)
#pragma unroll
                    for (int m = 0; m < 4; ++m) { float* rowp = GLR + (size_t)(row0 + ai * HALF + m * 16) * 16 + 8 * fq;
                        *(f32x4*)(rowp) = acc[ai][0][m][0]; *(f32x4*)(rowp + 4) = acc[ai][0][m][1]; }
            }
        }
    }
};
struct EpiMerge {
    static constexpr bool PERM = true, AFTER_DRAIN = false, MID_HOOK = true;
    const bf16_t* PB; bf16_t* MG;
    __device__ __forceinline__ void mid(f32x4 (&acc)[2][2][4][2], const Unit& u, int wr, int wc, int fr, int fq) const {
        int opq; asm volatile("v_mov_b32 %0, 0" : "=v"(opq));
        const int row0 = u.pm * BM + wr * 64 + fr + opq, col0 = u.pn * BM + wc * 32 + 8 * fq;
#pragma unroll
        for (int ai = 0; ai < 2; ++ai)
#pragma unroll
            for (int m = 0; m < 4; ++m) { const bf16_t* rowp = PB + (size_t)(row0 + ai * HALF + m * 16) * NPB + col0;
#pragma unroll
                for (int bj = 0; bj < 2; ++bj) {
                    const u32x4 a = *(const u32x4*)(rowp + B_GA + bj * HALF), b = *(const u32x4*)(rowp + B_GB + bj * HALF);
                    f32x4 r0, r1;
                    r0[0] = bflo(a.x) * __builtin_amdgcn_rcpf(bflo(b.x)); r0[1] = bfhi(a.x) * __builtin_amdgcn_rcpf(bfhi(b.x));
                    r0[2] = bflo(a.y) * __builtin_amdgcn_rcpf(bflo(b.y)); r0[3] = bfhi(a.y) * __builtin_amdgcn_rcpf(bfhi(b.y));
                    r1[0] = bflo(a.z) * __builtin_amdgcn_rcpf(bflo(b.z)); r1[1] = bfhi(a.z) * __builtin_amdgcn_rcpf(bfhi(b.z));
                    r1[2] = bflo(a.w) * __builtin_amdgcn_rcpf(bflo(b.w)); r1[3] = bfhi(a.w) * __builtin_amdgcn_rcpf(bfhi(b.w));
                    acc[ai][bj][m][0] = acc[ai][bj][m][0] * r0; acc[ai][bj][m][1] = acc[ai][bj][m][1] * r1; }
                __builtin_amdgcn_sched_barrier(0); }
    }
    __device__ __forceinline__ void operator()(const f32x4 (&acc)[2][2][4][2], const Unit& u, int wr, int wc, int fr, int fq) const {
        const int row0 = u.pm * BM + wr * 64 + fr, col0 = u.pn * BM + wc * 32 + 8 * fq;
#pragma unroll
        for (int ai = 0; ai < 2; ++ai)
#pragma unroll
            for (int m = 0; m < 4; ++m) { const size_t row = (size_t)(row0 + ai * HALF + m * 16); const bf16_t* gp = PB + row * NPB + B_GB + col0; bf16_t* op = MG + row * DM + col0;
#pragma unroll
                for (int bj = 0; bj < 2; ++bj) { const u32x4 b = *(const u32x4*)(gp + bj * HALF);
                    const f32x4 v0 = acc[ai][bj][m][0], v1 = acc[ai][bj][m][1];
                    u32x4 w; w.x = cvt_pk_bf16(v0[0] * bflo(b.x), v0[1] * bfhi(b.x)); w.y = cvt_pk_bf16(v0[2] * bflo(b.y), v0[3] * bfhi(b.y));
                    w.z = cvt_pk_bf16(v1[0] * bflo(b.z), v1[1] * bfhi(b.z)); w.w = cvt_pk_bf16(v1[2] * bflo(b.w), v1[3] * bfhi(b.w));
                    *(u32x4*)(op + bj * HALF) = w; } }
    }
};
struct EpiOut {
    static constexpr bool PERM = true, AFTER_DRAIN = false, MID_HOOK = false;
    const float* X; float* O;
    __device__ __forceinline__ void operator()(const f32x4 (&acc)[2][2][4][2], const Unit& u, int wr, int wc, int fr, int fq) const {
        const int row0 = u.pm * BM + wr * 64 + fr, col0 = u.pn * BM + wc * 32 + 8 * fq;
#pragma unroll
        for (int ai = 0; ai < 2; ++ai)
#pragma unroll
            for (int m = 0; m < 4; ++m) { const size_t off = (size_t)(row0 + ai * HALF + m * 16) * DM + col0;
#pragma unroll
                for (int bj = 0; bj < 2; ++bj) { const float* xp = X + off + bj * HALF; float* op = O + off + bj * HALF;
                    const f32x4 x0 = *(const f32x4*)xp, x1 = *(const f32x4*)(xp + 4);
                    *(f32x4*)op = x0 + acc[ai][bj][m][0]; *(f32x4*)(op + 4) = x1 + acc[ai][bj][m][1]; } }
    }
};
}

struct Frame {
    LAS unsigned char* lds;
    int tid, lane, wave, vcu, G;
    const float *x, *norm_g, *w_in, *w_gate, *b_gate, *gla_g, *qn_g, *kn_g, *w_bg, *w_bm, *w_out;
    float* out;
    bf16 *WIN, *WCAT, *WOUT, *XN, *ACAT, *PA, *PB, *MG;
    float *GLR, *KMEAN, *OG;
    int* SEL;
};

__device__ __forceinline__ int win_src_col(int d) {
    if (d < 2048) return d;
    if (d < 5120) return d - 2048 + 3088;
    if (d < 6144) return d - 5120 + 2064;
    if (d < 7168) return d - 6144 + 6160;
    if (d < 11264) return d - 7168 + 7184;
    if (d < 11280) return d - 11264 + 2048;
    return -1;
}
template <bool MAPPED>
__device__ __forceinline__ void transpose_item(const float* W, int Nsrc, bf16* WT, int ldk, int koff, int k0, int n0, LAS float* scr, int lane) {
    const int nn = n0 + (lane & 31);
    const int sc = MAPPED ? win_src_col(nn) : nn;
#pragma unroll 8
    for (int i = 0; i < 32; ++i) { const int kk = 2 * i + (lane >> 5); scr[kk * 33 + (lane & 31)] = sc >= 0 ? W[(size_t)(k0 + kk) * Nsrc + sc] : 0.f; }
    LDS_WAIT(); asm volatile("" ::: "memory");
    const int c = lane & 7;
#pragma unroll
    for (int j = 0; j < 4; ++j) { const int n = (lane >> 3) + 8 * j; const LAS float* s = scr + (8 * c) * 33 + n;
        v4u o; o.x = pk2(s[0 * 33], s[1 * 33]); o.y = pk2(s[2 * 33], s[3 * 33]); o.z = pk2(s[4 * 33], s[5 * 33]); o.w = pk2(s[6 * 33], s[7 * 33]);
        *(GAS v4u*)(WT + (size_t)(n0 + n) * ldk + koff + k0 + 8 * c) = o; }
    LDS_WAIT(); asm volatile("" ::: "memory");
}
__device__ __forceinline__ void p0_prologue(Frame& F) {
    LAS float* scr = (LAS float*)(F.lds + RING_OFF + F.wave * 16384);
    const int gw = F.vcu * NWAVES + F.wave, NGW = F.G * NWAVES;
    constexpr int NB_IN = 11296 / 32, I_IN = (DM / 64) * NB_IN;
    constexpr int I_BG = (1024 / 64) * (DM / 32), I_OUT = (DM / 64) * (DM / 32);
    constexpr int NITEMS = I_IN + 2 * I_BG + I_OUT;
    for (int it = gw; it < NITEMS; it += NGW) {
        int r = it;
        if (r < I_IN) { const int kb = r / NB_IN, nb = r % NB_IN; transpose_item<true>(F.w_in, NSRC, F.WIN, DM, 0, 64 * kb, 32 * nb, scr, F.lane); continue; } r -= I_IN;
        if (r < I_BG) { const int kb = r / (DM / 32), nb = r % (DM / 32); transpose_item<false>(F.w_bg, DM, F.WCAT, 2048, 0, 64 * kb, 32 * nb, scr, F.lane); continue; } r -= I_BG;
        if (r < I_BG) { const int kb = r / (DM / 32), nb = r % (DM / 32); transpose_item<false>(F.w_bm, DM, F.WCAT, 2048, 1024, 64 * kb, 32 * nb, scr, F.lane); continue; } r -= I_BG;
        { const int kb = r / (DM / 32), nb = r % (DM / 32); transpose_item<false>(F.w_out, DM, F.WOUT, DM, 0, 64 * kb, 32 * nb, scr, F.lane); }
    }
    f32x4 g[8];
#pragma unroll
    for (int j = 0; j < 8; ++j) g[j] = ((const GAS f32x4*)F.norm_g)[64 * j + F.lane];
    for (int m = gw; m < T; m += NGW) {
        const GAS f32x4* xr = (const GAS f32x4*)(F.x + (size_t)m * DM) + F.lane;
        f32x4 v[8]; float s = 0.f;
#pragma unroll
        for (int j = 0; j < 8; ++j) { v[j] = xr[64 * j]; s += (v[j].x * v[j].x + v[j].y * v[j].y) + (v[j].z * v[j].z + v[j].w * v[j].w); }
        const float r = 1.0f / sqrtf(wave_sum(s) * (1.0f / DM) + NORM_EPS);
        GAS unsigned long long* o8 = (GAS unsigned long long*)(F.XN + (size_t)m * DM) + F.lane;
#pragma unroll
        for (int j = 0; j < 8; ++j) { const f32x4 y = v[j] * r * g[j]; o8[64 * j] = (unsigned long long)pk2(y.x, y.y) | ((unsigned long long)pk2(y.z, y.w) << 32); }
    }
}

__device__ __forceinline__ void m0_knorm(Frame& F) {
    LAS float* red = (LAS float*)(F.lds);
    const int rg = F.tid >> 4, l16 = F.tid & 15;
    for (int item = F.vcu; item < BATCH * NBLK * MH; item += F.G) {
        const int h = item % MH, blk = (item / MH) % NBLK, b = item / (MH * NBLK);
        float gk[8], cs[8];
#pragma unroll
        for (int e = 0; e < 8; ++e) { gk[e] = F.kn_g[l16 * 8 + e]; cs[e] = 0.f; }
        v4u raw[8];
#pragma unroll
        for (int it = 0; it < 8; ++it) raw[it] = *(const GAS v4u*)(F.PA + ((size_t)b * SEQ + blk * MBLK + it * 32 + rg) * NPA + A_MK + h * MDH + l16 * 8);
#pragma unroll
        for (int it = 0; it < 8; ++it) {
            bf16* p = F.PA + ((size_t)b * SEQ + blk * MBLK + it * 32 + rg) * NPA + A_MK + h * MDH + l16 * 8;
            float v[8];
            v[0] = bflo(raw[it].x); v[1] = bfhi(raw[it].x); v[2] = bflo(raw[it].y); v[3] = bfhi(raw[it].y); v[4] = bflo(raw[it].z); v[5] = bfhi(raw[it].z); v[6] = bflo(raw[it].w); v[7] = bfhi(raw[it].w);
            float ss = 0.f;
#pragma unroll
            for (int e = 0; e < 8; ++e) ss += v[e] * v[e];
            ss += __shfl_xor(ss, 1); ss += __shfl_xor(ss, 2); ss += __shfl_xor(ss, 4); ss += __shfl_xor(ss, 8);
            const float r = 1.0f / sqrtf(ss * (1.0f / MDH) + NORM_EPS);
#pragma unroll
            for (int e = 0; e < 8; ++e) { v[e] = v[e] * r * gk[e]; cs[e] += v[e]; }
            v4u o; o.x = pk2(v[0], v[1]); o.y = pk2(v[2], v[3]); o.z = pk2(v[4], v[5]); o.w = pk2(v[6], v[7]);
            *(GAS v4u*)p = o;
        }
        __syncthreads();
#pragma unroll
        for (int e = 0; e < 8; ++e) red[rg * 128 + l16 * 8 + e] = cs[e];
        __syncthreads();
        if (F.tid < 128) { float s = 0.f;
#pragma unroll 8
            for (int r = 0; r < 32; ++r) s += red[r * 128 + F.tid];
            F.KMEAN[((size_t)(b * MH + h) * NBLK + blk) * MDH + F.tid] = s * (1.0f / MBLK); }
    }
}

typedef float f32x16 __attribute__((ext_vector_type(16)));
typedef float f32x2 __attribute__((ext_vector_type(2)));
typedef short s16x4 __attribute__((ext_vector_type(4)));
typedef __bf16 bf16x2_t __attribute__((ext_vector_type(2)));
#define MFMA32(a, b, c) __builtin_amdgcn_mfma_f32_32x32x16_bf16((a), (b), (c), 0, 0, 0)
__device__ __forceinline__ unsigned pkbf(float lo, float hi) { f32x2 v; v.x = lo; v.y = hi; return __builtin_bit_cast(unsigned, __builtin_convertvector(v, bf16x2_t)); }
__device__ __forceinline__ unsigned off_b(unsigned row, unsigned ch) { return 256u * row + 16u * (ch ^ (((row & 3u) << 2) | ((row >> 2) & 3u))); }
__device__ __forceinline__ int crow(int reg, int h) { return (reg & 3) + 8 * (reg >> 2) + 4 * h; }
__device__ __forceinline__ bf16x8 tr_frag(LAS unsigned char* tile, int lane, int rowbase, int c) {
    const unsigned h = lane >> 5, blk = (lane >> 4) & 1, q = (lane & 15) >> 2, p = lane & 3;
    const unsigned a0 = off_b(rowbase + 8 * h + q, 4 * c + 2 * blk + (p >> 1)) + 8 * (p & 1);
    const unsigned a1 = off_b(rowbase + 8 * h + 4 + q, 4 * c + 2 * blk + (p >> 1)) + 8 * (p & 1);
    const s16x4 lo = __builtin_amdgcn_ds_read_tr16_b64_v4i16((LAS s16x4*)(tile + a0));
    const s16x4 hi = __builtin_amdgcn_ds_read_tr16_b64_v4i16((LAS s16x4*)(tile + a1));
    return __builtin_shufflevector(lo, hi, 0, 1, 2, 3, 4, 5, 6, 7);
}
__device__ __forceinline__ bf16x8 row_frag(LAS unsigned char* tile, int row, int s, int h) { return *(const LAS bf16x8*)(tile + off_b(row, 2 * s + h)); }
__device__ __forceinline__ bf16x8 perm_frag(LAS unsigned char* tile, int row, int kb, int s, int h) {
    const s16x4 lo = *(const LAS s16x4*)(tile + off_b(row, 4 * kb + 2 * s) + 8 * h);
    const s16x4 hi = *(const LAS s16x4*)(tile + off_b(row, 4 * kb + 2 * s + 1) + 8 * h);
    return __builtin_shufflevector(lo, hi, 0, 1, 2, 3, 4, 5, 6, 7);
}
__device__ __forceinline__ bf16x8 pack_acc(const f32x16& x, int s) {
    v4u p; p.x = pkbf(x[8 * s], x[8 * s + 1]); p.y = pkbf(x[8 * s + 2], x[8 * s + 3]); p.z = pkbf(x[8 * s + 4], x[8 * s + 5]); p.w = pkbf(x[8 * s + 6], x[8 * s + 7]);
    return __builtin_bit_cast(bf16x8, p);
}
constexpr int G_NC = 8, G_NG = (SEQ / 64) / G_NC;

__device__ __forceinline__ void gla_g1(Frame& F, float* DEC, float* DG, float* ULOC) {
    LAS unsigned char* KT = F.lds;
    LAS unsigned char* VT = F.lds + 16384;
    LAS float* glr = (LAS float*)(F.lds + 49152);
    LAS float* Wg = (LAS float*)(F.lds + 53248);
    LAS float* bg = (LAS float*)(F.lds + 61440);
    LAS float* tot = (LAS float*)(F.lds + 62464);
    LAS float* dvec = (LAS float*)(F.lds + 64512);
    const int w = F.wave;
    for (int item = F.vcu; item < BATCH * GH * G_NG; item += F.G) {
        const int g = item % G_NG, hd = (item / G_NG) % GH, b = item / (G_NG * GH);
        const int d = F.tid & 127, qr = F.tid >> 7;
        __syncthreads();
        for (int i = F.tid; i < 16 * 128; i += 512) Wg[i] = F.w_gate[(size_t)(i >> 7) * GWK + hd * GDK + (i & 127)];
        if (F.tid < 128) bg[F.tid] = F.b_gate[hd * GDK + F.tid];
        __syncthreads();
        float wg[16];
#pragma unroll
        for (int j = 0; j < 16; ++j) wg[j] = Wg[j * 128 + d];
        const float bias = bg[d];
        float Dg = 1.0f;
        f32x16 U[4];
#pragma unroll
        for (int mt = 0; mt < 4; ++mt)
#pragma unroll
            for (int i = 0; i < 16; ++i) U[mt][i] = 0.f;
        for (int c = 0; c < G_NC; ++c) {
            const int cc = g * G_NC + c; const size_t rowb = (size_t)b * SEQ + (size_t)cc * 64;
            int lane = F.lane; asm volatile("" : "+v"(lane));
            const int h2 = lane >> 5, r = lane & 31;
            int tido = F.tid; asm volatile("" : "+v"(tido));
            const int d = tido & 127, qr = tido >> 7;
            __syncthreads();
            for (int i = F.tid; i < 64 * 16; i += 512) glr[i] = F.GLR[rowb * 16 + i];
            for (int i = F.tid; i < 2048; i += 512) { const int row = i >> 5, c32 = i & 31;
                const v4u val = *(const GAS v4u*)(F.PA + (rowb + row) * NPA + A_GV + hd * GDV + c32 * 8);
                *(LAS v4u*)(VT + (c32 >> 4) * 16384 + off_b(row, c32 & 15)) = val; }
            __syncthreads();
            float loc[16]; float run = 0.f;
#pragma unroll
            for (int i = 0; i < 16; ++i) { const int row = 16 * qr + i; float z = bias;
#pragma unroll
                for (int j = 0; j < 16; ++j) z = fmaf(glr[row * 16 + j], wg[j], z);
                const float sp = __builtin_amdgcn_logf(1.0f + __builtin_amdgcn_exp2f(-fabsf(z) * 1.44269504089f)) * 0.69314718056f;
                run += (fminf(z, 0.f) - sp) * (1.0f / 16.0f); loc[i] = run; }
            tot[qr * 128 + d] = run;
            __syncthreads();
            float off = 0.f, total = 0.f;
#pragma unroll
            for (int q2 = 0; q2 < 4; ++q2) { const float tq = tot[q2 * 128 + d]; total += tq; off += (q2 < qr) ? tq : 0.f; }
            if (qr == 0) { const float dd = __builtin_amdgcn_exp2f(total * 1.44269504089f); dvec[d] = dd; DEC[((size_t)(b * GH + hd) * (SEQ / 64) + cc) * GDK + d] = dd; Dg *= dd; }
#pragma unroll
            for (int i = 0; i < 16; ++i) { const int row = 16 * qr + i; const float bb = loc[i] + off;
                bf16* p = F.PA + (rowb + row) * NPA + hd * GDK + d;
                const float eb = __builtin_amdgcn_exp2f(bb * 1.44269504089f), ebi = __builtin_amdgcn_exp2f(-bb * 1.44269504089f);
                const float qn = bf2f(p[A_GQ]) * eb, kn = bf2f(p[A_GK]) * ebi;
                const unsigned short kb16 = (unsigned short)f2bf(kn);
                p[A_GQ] = (unsigned short)f2bf(qn); p[A_GK] = kb16;
                *(LAS unsigned short*)(KT + off_b(row, d >> 3) + (d & 7) * 2) = kb16; }
            __syncthreads();
#pragma unroll
            for (int ks = 0; ks < 4; ++ks) { const bf16x8 Bf = tr_frag(VT + (w >> 2) * 16384, lane, 16 * ks, w & 3);
#pragma unroll
                for (int mt = 0; mt < 4; ++mt) { const bf16x8 Af = tr_frag(KT, lane, 16 * ks, mt); U[mt] = MFMA32(Af, Bf, U[mt]); } }
#pragma unroll
            for (int mt = 0; mt < 4; ++mt)
#pragma unroll
                for (int i = 0; i < 16; ++i) U[mt][i] *= dvec[32 * mt + crow(i, h2)];
        }
        float* up = ULOC + (size_t)((b * GH + hd) * G_NG + g) * GDK * GDV;
        { const int h2 = F.lane >> 5, r = F.lane & 31;
#pragma unroll
        for (int mt = 0; mt < 4; ++mt)
#pragma unroll
            for (int i = 0; i < 16; ++i) up[(size_t)(32 * mt + crow(i, h2)) * GDV + 32 * w + r] = U[mt][i]; }
        if (qr == 0) DG[((size_t)(b * GH + hd) * G_NG + g) * GDK + d] = Dg;
    }
}
__device__ __forceinline__ void gla_g2(Frame& F, const float* DG, float* ULOC) {
    const int gt = F.vcu * (NWAVES * 64) + F.tid, NT = F.G * NWAVES * 64;
    for (int e = gt; e < BATCH * GH * GDK * GDV; e += NT) {
        const int bh = e / (GDK * GDV), rem = e % (GDK * GDV), dk = rem / GDV;
        float S = 0.f;
#pragma unroll 8
        for (int g = 0; g < G_NG; ++g) { const size_t idx = (size_t)(bh * G_NG + g) * GDK * GDV + rem; const float u = ULOC[idx]; ULOC[idx] = S; S = fmaf(DG[(size_t)(bh * G_NG + g) * GDK + dk], S, u); }
    }
}
__device__ __forceinline__ void gla_g3(Frame& F, const float* DEC, const float* SST) {
    LAS unsigned char* QT = F.lds;
    LAS unsigned char* KT = F.lds + 16384;
    LAS unsigned char* VT = F.lds + 32768;
    LAS unsigned char* AT = F.lds + 65536;
    LAS float* dvec = (LAS float*)(F.lds + 75776);
    LAS float* red = (LAS float*)(F.lds + 76288);
    const int w = F.wave;
    for (int item = F.vcu; item < BATCH * GH * G_NG; item += F.G) {
        const int g = item % G_NG, hd = (item / G_NG) % GH, b = item / (G_NG * GH);
        f32x16 S[4];
        { const int h2 = F.lane >> 5, r = F.lane & 31; const float* sp = SST + (size_t)((b * GH + hd) * G_NG + g) * GDK * GDV;
#pragma unroll
          for (int mt = 0; mt < 4; ++mt)
#pragma unroll
              for (int i = 0; i < 16; ++i) S[mt][i] = sp[(size_t)(32 * mt + crow(i, h2)) * GDV + 32 * w + r]; }
        for (int c = 0; c < G_NC; ++c) {
            const int cc = g * G_NC + c; const size_t rowb = (size_t)b * SEQ + (size_t)cc * 64;
            int lane = F.lane; asm volatile("" : "+v"(lane));
            const int h2 = lane >> 5, r = lane & 31;
            __syncthreads();
            for (int i = F.tid; i < 1024; i += 512) { const int row = i >> 4, ch = i & 15; const bf16* p = F.PA + (rowb + row) * NPA + hd * GDK + ch * 8;
                *(LAS v4u*)(QT + off_b(row, ch)) = *(const GAS v4u*)(p + A_GQ); *(LAS v4u*)(KT + off_b(row, ch)) = *(const GAS v4u*)(p + A_GK); }
            for (int i = F.tid; i < 2048; i += 512) { const int row = i >> 5, c32 = i & 31;
                *(LAS v4u*)(VT + (c32 >> 4) * 16384 + off_b(row, c32 & 15)) = *(const GAS v4u*)(F.PA + (rowb + row) * NPA + A_GV + hd * GDV + c32 * 8); }
            if (F.tid < 128) dvec[F.tid] = DEC[((size_t)(b * GH + hd) * (SEQ / 64) + cc) * GDK + F.tid];
            __syncthreads();
            if (w < 3) {
                const int tj = w >> 1, ti = (w + 1) >> 1;
                f32x16 a;
#pragma unroll
                for (int i = 0; i < 16; ++i) a[i] = 0.f;
#pragma unroll
                for (int s = 0; s < 8; ++s) a = MFMA32(row_frag(KT, 32 * tj + r, s, h2), row_frag(QT, 32 * ti + r, s, h2), a);
                const int ii = 32 * ti + r;
#pragma unroll
                for (int g4 = 0; g4 < 4; ++g4) { const int j0 = 32 * tj + 8 * g4 + 4 * h2;
                    const float v0 = (j0 + 0 <= ii) ? a[4 * g4 + 0] : 0.f, v1 = (j0 + 1 <= ii) ? a[4 * g4 + 1] : 0.f, v2 = (j0 + 2 <= ii) ? a[4 * g4 + 2] : 0.f, v3 = (j0 + 3 <= ii) ? a[4 * g4 + 3] : 0.f;
                    unsigned long long pk = (unsigned long long)pkbf(v0, v1) | ((unsigned long long)pkbf(v2, v3) << 32);
                    *(LAS unsigned long long*)(AT + ii * 144 + j0 * 2) = pk; }
            }
            __syncthreads();
            f32x16 Z[2];
#pragma unroll
            for (int i = 0; i < 16; ++i) { Z[0][i] = 0.f; Z[1][i] = 0.f; }
#pragma unroll
            for (int mt = 0; mt < 4; ++mt)
#pragma unroll
                for (int s = 0; s < 2; ++s) { const bf16x8 Af = pack_acc(S[mt], s);
                    Z[0] = MFMA32(Af, perm_frag(QT, r, mt, s, h2), Z[0]); Z[1] = MFMA32(Af, perm_frag(QT, 32 + r, mt, s, h2), Z[1]); }
            bf16x8 Vf[4];
#pragma unroll
            for (int ks = 0; ks < 4; ++ks) Vf[ks] = tr_frag(VT + (w >> 2) * 16384, lane, 16 * ks, w & 3);
#pragma unroll
            for (int ks = 0; ks < 4; ++ks) {
                if (ks < 2) Z[0] = MFMA32(Vf[ks], *(const LAS bf16x8*)(AT + r * 144 + (16 * ks + 8 * h2) * 2), Z[0]);
                Z[1] = MFMA32(Vf[ks], *(const LAS bf16x8*)(AT + (32 + r) * 144 + (16 * ks + 8 * h2) * 2), Z[1]); }
#pragma unroll
            for (int tt = 0; tt < 2; ++tt) { float ss = 0.f;
#pragma unroll
                for (int i = 0; i < 16; ++i) ss = fmaf(Z[tt][i], Z[tt][i], ss);
                ss += __shfl_xor(ss, 32);
                if (lane < 32) red[w * 64 + 32 * tt + r] = ss; }
            __syncthreads();
#pragma unroll
            for (int tt = 0; tt < 2; ++tt) { float tsum = 0.f;
#pragma unroll
                for (int w2 = 0; w2 < 8; ++w2) tsum += red[w2 * 64 + 32 * tt + r];
                const float rs = 1.0f / sqrtf(tsum * (1.0f / GDV) + NORM_EPS);
                const size_t row = rowb + 32 * tt + r;
#pragma unroll
                for (int g4 = 0; g4 < 4; ++g4) { const int dv = 32 * w + 8 * g4 + 4 * h2; const f32x4 gg = *(const f32x4*)(F.gla_g + dv);
                    const unsigned long long gs = *(const GAS unsigned long long*)(F.PB + row * NPB + B_GS + hd * GDV + dv); const unsigned lo = (unsigned)gs, hi = (unsigned)(gs >> 32);
                    const unsigned long long o = (unsigned long long)pkbf(Z[tt][4 * g4] * rs * gg.x * bflo(lo), Z[tt][4 * g4 + 1] * rs * gg.y * bfhi(lo))
                                               | ((unsigned long long)pkbf(Z[tt][4 * g4 + 2] * rs * gg.z * bflo(hi), Z[tt][4 * g4 + 3] * rs * gg.w * bfhi(hi)) << 32);
                    *(GAS unsigned long long*)(F.ACAT + row * 2048 + hd * GDV + dv) = o; } }
#pragma unroll
            for (int ks = 0; ks < 4; ++ks)
#pragma unroll
                for (int mt = 0; mt < 4; ++mt) S[mt] = MFMA32(tr_frag(KT, lane, 16 * ks, mt), Vf[ks], S[mt]);
#pragma unroll
            for (int mt = 0; mt < 4; ++mt)
#pragma unroll
                for (int i = 0; i < 16; ++i) S[mt][i] *= dvec[32 * mt + crow(i, h2)];
        }
    }
}


constexpr size_t OUT_PART = 0;
constexpr size_t OUT_PL = 192 * MiB;
constexpr int LDS_QLIST = 131072 + 1024, LDS_QCNT = LDS_QLIST + 9216;
constexpr int M2_SEG = 2048;

__device__ __forceinline__ bf16x8 tr_frag_perm(LAS unsigned char* tile, int lane, int rowbase, int c) {
    const unsigned h = lane >> 5, blk = (lane >> 4) & 1, q = (lane & 15) >> 2, p = lane & 3;
    const unsigned a0 = off_b(rowbase + 4 * h + q, 4 * c + 2 * blk + (p >> 1)) + 8 * (p & 1);
    const unsigned a1 = off_b(rowbase + 8 + 4 * h + q, 4 * c + 2 * blk + (p >> 1)) + 8 * (p & 1);
    const s16x4 lo = __builtin_amdgcn_ds_read_tr16_b64_v4i16((LAS s16x4*)(tile + a0));
    const s16x4 hi = __builtin_amdgcn_ds_read_tr16_b64_v4i16((LAS s16x4*)(tile + a1));
    return __builtin_shufflevector(lo, hi, 0, 1, 2, 3, 4, 5, 6, 7);
}
__device__ __forceinline__ bool moba_skip(float slope2, int t, int j, float M2) { return slope2 * (float)(t - (j * MBLK + MBLK - 1)) > 150.04029f + 2.0f * M2; }
__device__ __forceinline__ float moba_mfix(Frame& F) {
    float a = fmaxf(fabsf(F.qn_g[F.lane]), fabsf(F.qn_g[64 + F.lane])), b = fmaxf(fabsf(F.kn_g[F.lane]), fabsf(F.kn_g[64 + F.lane]));
    a = wave_max(a); b = wave_max(b);
    return 11.3137085f * a * b * 1.03f * 1.44269504089f;
}
__device__ __forceinline__ void moba_stage_kv(Frame& F, size_t row0, int hd) {
    const int lane = F.lane, w = F.wave;
    const int rl = lane >> 4, slot = lane & 15;
#pragma unroll
    for (int i = 0; i < 8; ++i) { const int pc = w + 8 * i; const int row = 4 * pc + rl; const int ch = slot ^ (((row & 3) << 2) | ((row >> 2) & 3));
        const bf16* p = F.PA + (row0 + row) * NPA + hd * MDH + ch * 8;
        __builtin_amdgcn_global_load_lds((const unsigned*)(p + A_MK), (LAS unsigned*)(F.lds + pc * 1024), 16, 0, 0);
        __builtin_amdgcn_global_load_lds((const unsigned*)(p + A_MV), (LAS unsigned*)(F.lds + 65536 + pc * 1024), 16, 0, 0); }
}
template <bool CAUSAL>
__device__ __forceinline__ void moba_core(LAS unsigned char* Kt, LAS unsigned char* Vt, const bf16* qrow, int lane, int nkt, int wdiag, float c_t, float slope2, float keybase, f32x16 (&O)[4], float& l) {
    const int h2 = lane >> 5, r = lane & 31;
    bf16x8 Qf[8];
#pragma unroll
    for (int s = 0; s < 8; ++s) Qf[s] = *(const GAS bf16x8*)(qrow + 16 * s + 8 * h2);
#pragma unroll
    for (int db = 0; db < 4; ++db)
#pragma unroll
        for (int i = 0; i < 16; ++i) O[db][i] = 0.f;
    l = 0.f;
    bf16x8 Kf[8];
#pragma unroll
    for (int s = 0; s < 8; ++s) Kf[s] = row_frag(Kt, r, s, h2);
#pragma unroll 1
    for (int kt = 0; kt < nkt; ++kt) {
        f32x16 a;
#pragma unroll
        for (int i = 0; i < 16; ++i) a[i] = 0.f;
#pragma unroll
        for (int s = 0; s < 8; ++s) a = MFMA32(Kf[s], Qf[s], a);
        __builtin_amdgcn_sched_barrier(0);
        bf16x8 Vf[2][4];
#pragma unroll
        for (int s2 = 0; s2 < 2; ++s2)
#pragma unroll
            for (int db = 0; db < 4; ++db) Vf[s2][db] = tr_frag_perm(Vt, lane, 32 * kt + 16 * s2, db);
#pragma unroll
        for (int s = 0; s < 8; ++s) Kf[s] = row_frag(Kt, 32 * (kt + 1) + r, s, h2);
        __builtin_amdgcn_sched_barrier(0);
        const float kb = keybase + (float)(32 * kt + 4 * h2);
#pragma unroll
        for (int i = 0; i < 16; ++i) { const int cr = (i & 3) + 8 * (i >> 2);
            float p = __builtin_amdgcn_exp2f(fmaf(a[i], 0.127517430f, fmaf(slope2, kb + (float)cr, c_t)));
            if (CAUSAL) { if (kt == wdiag && cr + 4 * h2 > r) p = 0.f; }
            a[i] = p; l += p; }
#pragma unroll
        for (int s2 = 0; s2 < 2; ++s2) { const bf16x8 Pf = pack_acc(a, s2);
#pragma unroll
            for (int db = 0; db < 4; ++db) O[db] = MFMA32(Vf[s2][db], Pf, O[db]); }
    }
}
__device__ __forceinline__ void top3_insert(float v, int j, float& b0, float& b1, float& b2, int& i0, int& i1, int& i2) {
    const bool c0 = (v > b0) || (v == b0 && (unsigned)j < (unsigned)i0), c1 = (v > b1) || (v == b1 && (unsigned)j < (unsigned)i1), c2 = (v > b2) || (v == b2 && (unsigned)j < (unsigned)i2);
    b2 = c1 ? b1 : (c2 ? v : b2); i2 = c1 ? i1 : (c2 ? j : i2);
    b1 = c0 ? b0 : (c1 ? v : b1); i1 = c0 ? i0 : (c1 ? j : i1);
    b0 = c0 ? v : b0; i0 = c0 ? j : i0;
}
__device__ __forceinline__ void m1_select(Frame& F, unsigned* SELB) {
    LAS unsigned char* KH = F.lds;
    LAS unsigned char* KL = F.lds + 16384;
    const int w = F.wave;
    constexpr int NIT = BATCH * MH * NBLK, PER = 4;
    int cur_bh = -1;
    for (int it0 = F.vcu * PER; it0 < NIT; it0 += F.G * PER)
        for (int item = it0; item < it0 + PER && item < NIT; ++item) {
            const int qb = item % NBLK, bh = item / NBLK, hd = bh % MH, b = bh / MH;
            int lane = F.lane; asm volatile("" : "+v"(lane));
            const int h2 = lane >> 5, r = lane & 31;
            if (bh != cur_bh) {
                __syncthreads();
                for (int i = F.tid; i < NBLK * MDH / 8; i += 512) { const int row = i >> 4, ch = i & 15; const float* kp = F.KMEAN + ((size_t)bh * NBLK + row) * MDH + ch * 8;
                    const f32x4 k0 = *(const f32x4*)kp, k1 = *(const f32x4*)(kp + 4);
                    v4u hi; hi.x = pkbf(k0.x, k0.y); hi.y = pkbf(k0.z, k0.w); hi.z = pkbf(k1.x, k1.y); hi.w = pkbf(k1.z, k1.w);
                    v4u lo; lo.x = pkbf(k0.x - bflo(hi.x), k0.y - bfhi(hi.x)); lo.y = pkbf(k0.z - bflo(hi.y), k0.w - bfhi(hi.y)); lo.z = pkbf(k1.x - bflo(hi.z), k1.y - bfhi(hi.z)); lo.w = pkbf(k1.z - bflo(hi.w), k1.w - bfhi(hi.w));
                    *(LAS v4u*)(KH + off_b(row, ch)) = hi; *(LAS v4u*)(KL + off_b(row, ch)) = lo; }
                __syncthreads();
                cur_bh = bh;
            }
            const int t = qb * MBLK + 32 * w + r;
            bf16* qp = F.PA + ((size_t)b * SEQ + t) * NPA + A_MQ + hd * MDH;
            v4u raw[8]; float ss = 0.f;
#pragma unroll
            for (int s = 0; s < 8; ++s) { raw[s] = *(const GAS v4u*)(qp + 16 * s + 8 * h2);
                ss += bflo(raw[s].x) * bflo(raw[s].x) + bfhi(raw[s].x) * bfhi(raw[s].x) + bflo(raw[s].y) * bflo(raw[s].y) + bfhi(raw[s].y) * bfhi(raw[s].y)
                    + bflo(raw[s].z) * bflo(raw[s].z) + bfhi(raw[s].z) * bfhi(raw[s].z) + bflo(raw[s].w) * bflo(raw[s].w) + bfhi(raw[s].w) * bfhi(raw[s].w); }
            ss += __shfl_xor(ss, 32);
            const float rs = 1.0f / sqrtf(ss * (1.0f / MDH) + NORM_EPS);
            bf16x8 Qf[8];
#pragma unroll
            for (int s = 0; s < 8; ++s) { const float* gp = F.qn_g + 16 * s + 8 * h2; const f32x4 g0 = *(const f32x4*)gp, g1 = *(const f32x4*)(gp + 4);
                v4u o; o.x = pkbf(bflo(raw[s].x) * rs * g0.x, bfhi(raw[s].x) * rs * g0.y); o.y = pkbf(bflo(raw[s].y) * rs * g0.z, bfhi(raw[s].y) * rs * g0.w);
                o.z = pkbf(bflo(raw[s].z) * rs * g1.x, bfhi(raw[s].z) * rs * g1.y); o.w = pkbf(bflo(raw[s].w) * rs * g1.z, bfhi(raw[s].w) * rs * g1.w);
                *(GAS v4u*)(qp + 16 * s + 8 * h2) = o; Qf[s] = __builtin_bit_cast(bf16x8, o); }
            float b0 = -3.0e38f, b1 = -3.0e38f, b2 = -3.0e38f; int i0 = -1, i1 = -1, i2 = -1;
#pragma unroll
            for (int mt = 0; mt < 2; ++mt) {
                if (32 * mt < qb) {
                    f32x16 a;
#pragma unroll
                    for (int i = 0; i < 16; ++i) a[i] = 0.f;
#pragma unroll
                    for (int s = 0; s < 8; ++s) { a = MFMA32(row_frag(KH, 32 * mt + r, s, h2), Qf[s], a); a = MFMA32(row_frag(KL, 32 * mt + r, s, h2), Qf[s], a); }
#pragma unroll
                    for (int i = 0; i < 16; ++i) { const int j = 32 * mt + (i & 3) + 8 * (i >> 2) + 4 * h2; top3_insert((j < qb) ? a[i] : -3.0e38f, (j < qb) ? j : -1, b0, b1, b2, i0, i1, i2); }
                }
            }
            { const float ob0 = __shfl_xor(b0, 32), ob1 = __shfl_xor(b1, 32), ob2 = __shfl_xor(b2, 32); const int oi0 = __shfl_xor(i0, 32), oi1 = __shfl_xor(i1, 32), oi2 = __shfl_xor(i2, 32);
              top3_insert(ob0, oi0, b0, b1, b2, i0, i1, i2); top3_insert(ob1, oi1, b0, b1, b2, i0, i1, i2); top3_insert(ob2, oi2, b0, b1, b2, i0, i1, i2); }
            if (h2 == 0) SELB[(size_t)bh * SEQ + t] = ((unsigned)i0 & 0xffu) | (((unsigned)i1 & 0xffu) << 8) | (((unsigned)i2 & 0xffu) << 16) | 0xff000000u;
        }
}
constexpr int CW_Q_M2 = 64;
constexpr int LDS_ITEM = 131072 + 512;
__device__ __forceinline__ void m2_sel(Frame& F, const unsigned* SELB, bf16* PART, float* PL, unsigned* ctl_q) {
    const float M2 = moba_mfix(F);
    LAS unsigned* qlist = (LAS unsigned*)(F.lds + LDS_QLIST); LAS unsigned* qcnt = (LAS unsigned*)(F.lds + LDS_QCNT); LAS unsigned* ldsitem = (LAS unsigned*)(F.lds + LDS_ITEM);
    const int w = F.wave;
    constexpr int NITEM = 63 * BATCH * MH;
    for (;;) {
        __syncthreads();
        if (F.tid == 0) { *ldsitem = __hip_atomic_fetch_add(ctl_q, 1u, __ATOMIC_RELAXED, __HIP_MEMORY_SCOPE_AGENT); *qcnt = 0u; }
        __syncthreads();
        const int L = (int)*ldsitem;
        if (L >= NITEM) break;
        const int bh = L % (BATCH * MH), j = L / (BATCH * MH), hd = bh % MH, b = bh / MH;
        int lane = F.lane; asm volatile("" : "+v"(lane));
        moba_stage_kv(F, (size_t)b * SEQ + (size_t)j * MBLK, hd);
        const float slope2 = __builtin_amdgcn_exp2f(-(float)(hd + 1)) * 1.44269504089f;
        const int qbeg = (j + 1) * MBLK, nseg = (SEQ - qbeg + M2_SEG - 1) / M2_SEG;
        for (int sg = 0; sg < nseg; ++sg) {
            const int t4 = qbeg + sg * M2_SEG + 4 * F.tid;
            if (t4 < SEQ) { const v4u sv = *(const GAS v4u*)(SELB + (size_t)bh * SEQ + t4);
#pragma unroll
                for (int e = 0; e < 4; ++e) { const unsigned x = e == 0 ? sv.x : (e == 1 ? sv.y : (e == 2 ? sv.z : sv.w));
                    const int slot = ((x & 0xffu) == (unsigned)j) ? 0 : ((((x >> 8) & 0xffu) == (unsigned)j) ? 1 : ((((x >> 16) & 0xffu) == (unsigned)j) ? 2 : -1));
                    if (slot >= 0 && !moba_skip(slope2, t4 + e, j, M2)) { const unsigned idx = atomicAdd((unsigned*)qcnt, 1u); qlist[idx] = (unsigned)(t4 + e) | ((unsigned)slot << 16); } } }
            if (sg == 0) asm volatile("s_waitcnt vmcnt(0)" ::: "memory");
            __syncthreads();
            const int n = (int)*qcnt;
            const int npass = (sg == nseg - 1) ? (n + 255) / 256 : n / 256;
#if defined(PROBE_M2) && PROBE_M2 == 1
            for (int rep2 = 0; rep2 < 2; ++rep2)
#endif
            for (int p = 0; p < npass; ++p) {
                const int base = 256 * p + 32 * w;
                if (base < n) {
                    const int idx = base + (lane & 31); const bool valid = idx < n;
                    const unsigned e = qlist[valid ? idx : base]; const int t = (int)(e & 0xffffu), slot = (int)(e >> 16);
                    f32x16 O[4]; float l;
#if defined(PROBE_M2) && PROBE_M2 == 2
                    moba_core<false>(F.lds, F.lds + 65536, F.PA + ((size_t)b * SEQ + t) * NPA + A_MQ + hd * MDH, lane, 8, 0, -slope2 * (float)t - M2, slope2, (float)(j * MBLK), O, l);
                    asm volatile("" :: "v"(O[0][0]), "v"(O[1][1]), "v"(O[2][2]), "v"(O[3][3]), "v"(l));
#endif
                    moba_core<false>(F.lds, F.lds + 65536, F.PA + ((size_t)b * SEQ + t) * NPA + A_MQ + hd * MDH, lane, 8, 0, -slope2 * (float)t - M2, slope2, (float)(j * MBLK), O, l);
                    l += __shfl_xor(l, 32);
                    if (valid) { const size_t pr = ((size_t)bh * SEQ + t) * 3 + slot; bf16* po = PART + pr * MDH + 64 * (lane >> 5);
#pragma unroll
                        for (int db = 0; db < 4; ++db)
#pragma unroll
                            for (int g2 = 0; g2 < 2; ++g2) { v4u o; o.x = pkbf(O[db][8 * g2], O[db][8 * g2 + 1]); o.y = pkbf(O[db][8 * g2 + 2], O[db][8 * g2 + 3]); o.z = pkbf(O[db][8 * g2 + 4], O[db][8 * g2 + 5]); o.w = pkbf(O[db][8 * g2 + 6], O[db][8 * g2 + 7]);
                                *(GAS v4u*)(po + 16 * db + 8 * g2) = o; }
                        if (lane < 32) PL[((size_t)bh * SEQ + t) * 4 + slot] = l; }
                }
            }
            if (sg < nseg - 1) {
                const int rem = n - 256 * npass;
                __syncthreads();
                unsigned tmp = 0u; if (npass > 0 && F.tid < rem) tmp = qlist[256 * npass + F.tid];
                __syncthreads();
                if (npass > 0 && F.tid < rem) qlist[F.tid] = tmp;
                if (F.tid == 0) *qcnt = (unsigned)rem;
                __syncthreads();
            }
        }
    }
}
__device__ __forceinline__ void m3_own(Frame& F, const unsigned* SELB, const bf16* PART, const float* PL) {
    const float M2 = moba_mfix(F);
    const int w = F.wave;
    for (int item = F.vcu; item < BATCH * MH * NBLK; item += F.G) {
        const int hd = item % MH, qb = (item / MH) % NBLK, b = item / (MH * NBLK), bh = b * MH + hd;
        int lane = F.lane; asm volatile("" : "+v"(lane));
        __syncthreads();
        moba_stage_kv(F, (size_t)b * SEQ + (size_t)qb * MBLK, hd);
        const int t = qb * MBLK + 32 * w + (lane & 31);
        const float slope2 = __builtin_amdgcn_exp2f(-(float)(hd + 1)) * 1.44269504089f;
        const unsigned sx = SELB[(size_t)bh * SEQ + t];
        asm volatile("s_waitcnt vmcnt(0)" ::: "memory");
        __syncthreads();
#if defined(PROBE_M3) && PROBE_M3 == 2
        moba_stage_kv(F, (size_t)b * SEQ + (size_t)qb * MBLK, hd); asm volatile("s_waitcnt vmcnt(0)" ::: "memory"); __syncthreads();
#endif
        f32x16 O[4]; float l;
#if defined(PROBE_M3) && PROBE_M3 == 1
        moba_core<true>(F.lds, F.lds + 65536, F.PA + ((size_t)b * SEQ + t) * NPA + A_MQ + hd * MDH, lane, w + 1, w, -slope2 * (float)t - M2, slope2, (float)(qb * MBLK), O, l);
        asm volatile("" :: "v"(O[0][0]), "v"(O[1][1]), "v"(O[2][2]), "v"(O[3][3]), "v"(l));
#endif
        moba_core<true>(F.lds, F.lds + 65536, F.PA + ((size_t)b * SEQ + t) * NPA + A_MQ + hd * MDH, lane, w + 1, w, -slope2 * (float)t - M2, slope2, (float)(qb * MBLK), O, l);
        l += __shfl_xor(l, 32);
        __syncthreads();
        { LAS unsigned char* ot = F.lds + w * 16384; const int r = lane & 31, h2 = lane >> 5;
          LAS float* lv = (LAS float*)(F.lds + LDS_QLIST) + w * 32; LAS unsigned* sv = (LAS unsigned*)(F.lds + LDS_QLIST + 1024) + w * 32;
#pragma unroll
          for (int db = 0; db < 4; ++db)
#pragma unroll
              for (int g4 = 0; g4 < 4; ++g4) { const int ch = 8 * db + 2 * g4 + h2;
                  f32x4 v; v.x = O[db][4 * g4]; v.y = O[db][4 * g4 + 1]; v.z = O[db][4 * g4 + 2]; v.w = O[db][4 * g4 + 3];
                  *(LAS f32x4*)(ot + r * 512 + 16 * (ch ^ r)) = v; }
          if (h2 == 0) { lv[r] = l; sv[r] = sx; }
          LDS_WAIT(); asm volatile("" ::: "memory");
          const int c16 = lane & 15, rl = lane >> 4;
#if defined(PROBE_M3) && PROBE_M3 == 3
          for (int rep3 = 0; rep3 < 2; ++rep3)
#endif
#pragma unroll
          for (int it = 0; it < 8; ++it) { const int rr = 4 * it + rl; const int tt = qb * MBLK + 32 * w + rr; const size_t row = (size_t)b * SEQ + tt;
              const f32x4 o0 = *(const LAS f32x4*)(ot + rr * 512 + 16 * ((2 * c16) ^ rr)), o1 = *(const LAS f32x4*)(ot + rr * 512 + 16 * ((2 * c16 + 1) ^ rr));
              float ll = lv[rr]; const unsigned sxx = sv[rr];
              float v[8] = {o0.x, o0.y, o0.z, o0.w, o1.x, o1.y, o1.z, o1.w};
              const bf16* po = PART + (((size_t)bh * SEQ + tt) * 3) * MDH + 4 * c16;
              const f32x4 pl = *(const f32x4*)(PL + ((size_t)bh * SEQ + tt) * 4);
#pragma unroll
              for (int slot = 0; slot < 3; ++slot) { const unsigned sj = (sxx >> (8 * slot)) & 0xffu; const bool ok = sj != 0xffu && !moba_skip(slope2, tt, (int)sj, M2);
                  const unsigned long long p0 = *(const GAS unsigned long long*)(po + slot * MDH), p1 = *(const GAS unsigned long long*)(po + slot * MDH + 64);
                  ll += ok ? (slot == 0 ? pl.x : (slot == 1 ? pl.y : pl.z)) : 0.f;
                  v[0] += ok ? bflo((unsigned)p0) : 0.f; v[1] += ok ? bfhi((unsigned)p0) : 0.f; v[2] += ok ? bflo((unsigned)(p0 >> 32)) : 0.f; v[3] += ok ? bfhi((unsigned)(p0 >> 32)) : 0.f;
                  v[4] += ok ? bflo((unsigned)p1) : 0.f; v[5] += ok ? bfhi((unsigned)p1) : 0.f; v[6] += ok ? bflo((unsigned)(p1 >> 32)) : 0.f; v[7] += ok ? bfhi((unsigned)(p1 >> 32)) : 0.f; }
              const float inv = 1.0f / ll;
              const v4u gs = *(const GAS v4u*)(F.PB + row * NPB + B_MS + hd * MDH + 8 * c16);
              v4u o; o.x = pkbf(v[0] * inv * bflo(gs.x), v[1] * inv * bfhi(gs.x)); o.y = pkbf(v[2] * inv * bflo(gs.y), v[3] * inv * bfhi(gs.y));
              o.z = pkbf(v[4] * inv * bflo(gs.z), v[5] * inv * bfhi(gs.z)); o.w = pkbf(v[6] * inv * bflo(gs.w), v[7] * inv * bfhi(gs.w));
              *(GAS v4u*)(F.ACAT + row * 2048 + 1024 + hd * MDH + 8 * c16) = o; }
        }
    }
}

constexpr int N_PHASES = 10;
#ifndef MK_N_LAUNCHES
#define MK_N_LAUNCHES 1
#endif
struct Args { const float* in[11]; float* out; unsigned char* ws; int ph_lo, ph_hi; };
__global__ void __launch_bounds__(NWAVES * 64, 2) mk_fwd(Args args) {
    extern __shared__ __attribute__((aligned(16))) unsigned char lds[];
    Frame F;
    F.lds = (LAS unsigned char*)lds;
    F.tid = threadIdx.x; F.lane = F.tid & 63; F.wave = __builtin_amdgcn_readfirstlane(F.tid >> 6);
    F.G = gridDim.x; { const int bx = blockIdx.x; F.vcu = (F.G % 8 == 0) ? (bx % 8) * (F.G / 8) + bx / 8 : bx; }
    unsigned char* ws = args.ws;
    F.x = args.in[0]; F.norm_g = args.in[1]; F.w_in = args.in[2]; F.w_gate = args.in[3]; F.b_gate = args.in[4]; F.gla_g = args.in[5];
    F.qn_g = args.in[6]; F.kn_g = args.in[7]; F.w_bg = args.in[8]; F.w_bm = args.in[9]; F.w_out = args.in[10]; F.out = args.out;
    F.WIN = (bf16*)(ws + WS_WIN); F.WCAT = (bf16*)(ws + WS_WCAT); F.WOUT = (bf16*)(ws + WS_WOUT); F.XN = (bf16*)(ws + WS_XN); F.ACAT = (bf16*)(ws + WS_ACAT);
    F.PA = (bf16*)(ws + WS_PA); F.PB = (bf16*)(ws + WS_PB); F.MG = (bf16*)(ws + WS_MG);
    F.GLR = (float*)(ws + WS_GLR); F.KMEAN = (float*)(ws + WS_KMEAN); F.OG = args.out; F.SEL = (int*)(ws + WS_SEL);
    volatile LAS unsigned* MISC = (volatile LAS unsigned*)(F.lds + MISC_OFF);
    for (int u = F.tid; u < (LDS_BYTES - LDSCTL_OFF) / 4; u += NWAVES * 64) ((LAS unsigned*)(F.lds + LDSCTL_OFF))[u] = 0u;
    __syncthreads();
    const int lo = args.ph_lo, hi = args.ph_hi;
    XcdBarrier bar; bar.bar = (unsigned*)(ws + WS_CTL) + CW_BAR; bar.x = 0; bar.st = nullptr;
    if (hi - lo > 1) bar = xcd_barrier_post((unsigned*)(ws + WS_CTL) + CW_BAR, MISC + 8);
#ifndef PH_MASK
#define PH_MASK 0x3ff
#endif
#define IN(k) (((PH_MASK >> (k)) & 1) && lo <= (k) && (k) < hi)
#define SEAM(k) do { if (IN(k) && IN((k) + 1)) xcd_barrier(bar); } while (0)
#ifndef SPLIT_MASK
#define SPLIT_MASK 0
#endif
#ifndef DUP_MASK
#define DUP_MASK 0
#endif
#define REPS(k) (((DUP_MASK >> (k)) & 1) ? 2 : 1)

    bf16* const PARTp = (bf16*)((unsigned char*)args.out + OUT_PART); float* const PLp = (float*)((unsigned char*)args.out + OUT_PL); unsigned* const SELBp = (unsigned*)(ws + WS_SEL);
    float* const DECp = (float*)(ws + WS_DEC); float* const DGp = (float*)(ws + WS_DG); float* const ULOCp = (float*)(ws + WS_ULOC);
    if (IN(0)) { p0_prologue(F); } SEAM(0);
    if (IN(1)) {
        pg8::Gemm g{F.XN, F.WIN, T, NP, DM}; pg8::StaticOrder S; S.init(T, NP, F.G, (int)blockIdx.x, REPS(1));
        pg8::EpiProj E{F.PA, F.PB, F.GLR};
        pg8::gemm_phase<pg8::EpiProj, pg8::StaticOrder, true, true>(F.lds + RING_OFF, g, S, E);
    } SEAM(1);
    if (IN(2)) { m0_knorm(F); } SEAM(2);
    if (IN(3)) { for (int rep_ = 0; rep_ < REPS(3); ++rep_) m1_select(F, SELBp); } SEAM(3);
    if (IN(4)) { for (int rep_ = 0; rep_ < REPS(4); ++rep_) { if (rep_) xcd_barrier(bar); m2_sel(F, SELBp, PARTp, PLp, (unsigned*)(ws + WS_CTL) + CW_Q_M2 + 64 * rep_); } } SEAM(4);
    if (IN(5)) { for (int rep_ = 0; rep_ < REPS(5); ++rep_) { if (rep_) xcd_barrier(bar); m3_own(F, SELBp, PARTp, PLp); } gla_g1(F, DECp, DGp, ULOCp); } SEAM(5);
    if (IN(6)) { gla_g2(F, DGp, ULOCp); } SEAM(6);
    if (IN(7)) { for (int rep_ = 0; rep_ < REPS(8); ++rep_) gla_g3(F, DECp, ULOCp); } SEAM(7);
    if (IN(8)) {
        pg8::Gemm g{F.ACAT, F.WCAT, T, DM, 2048}; pg8::StaticOrder S; S.init(T, DM, F.G, (int)blockIdx.x, REPS(9));
        pg8::EpiMerge E{F.PB, F.MG};
        pg8::gemm_phase<pg8::EpiMerge, pg8::StaticOrder, true, true>(F.lds + RING_OFF, g, S, E);
    } SEAM(8);
    if (IN(9)) {
        pg8::Gemm g{F.MG, F.WOUT, T, DM, DM}; pg8::StaticOrder S; S.init(T, DM, F.G, (int)blockIdx.x, REPS(10));
        pg8::EpiOut E{F.x, F.out};
        pg8::gemm_phase<pg8::EpiOut, pg8::StaticOrder, true, true>(F.lds + RING_OFF, g, S, E);
    }
#undef IN
#undef SEAM
}

extern "C" void kernel_launch(void* const* d_in, const int* in_sizes, int n_in, void* d_out, int out_size, void* d_ws, size_t ws_size, hipStream_t stream) {
    static int grid = 0;
    if (grid == 0) {
        if (n_in != 11 || in_sizes[0] != T * DM || out_size != T * DM || ws_size < WS_END) { fprintf(stderr, "kernel_launch: unexpected shapes (n_in %d, in0 %d, out %d, ws %zu)\n", n_in, n_in > 0 ? in_sizes[0] : -1, out_size, ws_size); grid = -1; return; }
        int dev = 0, cus = 0, per_cu = 0;
        if (hipGetDevice(&dev) != hipSuccess || hipDeviceGetAttribute(&cus, hipDeviceAttributeMultiprocessorCount, dev) != hipSuccess) { grid = -1; return; }
        if (hipFuncSetAttribute((const void*)mk_fwd, hipFuncAttributeMaxDynamicSharedMemorySize, LDS_BYTES) != hipSuccess) { fprintf(stderr, "kernel_launch: hipFuncSetAttribute failed\n"); grid = -1; return; }
        if (hipOccupancyMaxActiveBlocksPerMultiprocessor(&per_cu, (const void*)mk_fwd, NWAVES * 64, LDS_BYTES) != hipSuccess || per_cu < 1) { fprintf(stderr, "kernel_launch: occupancy query says %d blocks per CU\n", per_cu); per_cu = 1; }
        (void)hipGetLastError();
        grid = cus;
    }
    if (grid < 0) return;
    (void)hipMemsetAsync((char*)d_ws + WS_CTL, 0, CTL_ZERO_BYTES, stream);
    Args a{};
    for (int i = 0; i < 11; ++i) a.in[i] = (const float*)d_in[i];
    a.out = (float*)d_out; a.ws = (unsigned char*)d_ws;
    constexpr int NL = MK_N_LAUNCHES;
    for (int li = 0; li < NL; ++li) {
        a.ph_lo = (NL == 1) ? 0 : li; a.ph_hi = (NL == 1) ? N_PHASES : li + 1;
        void* kargs[] = {(void*)&a};
        hipError_t e = hipLaunchCooperativeKernel((const void*)mk_fwd, dim3(grid), dim3(NWAVES * 64), kargs, LDS_BYTES, stream);
        if (e != hipSuccess) { fprintf(stderr, "kernel_launch: cooperative launch failed: %s (grid %d)\n", hipGetErrorString(e), grid); (void)hipGetLastError(); }
    }
}
```
